# Optimizing an MI355X kernel written in HIP

```python
import math
import jax, jax.numpy as jnp
from jax import lax
import numpy as np


D_MODEL = 1024
BATCH = 4
SEQ = 8192
DEPTH = 1

CHUNK = 64
Q_BLOCK = 128
RMS_EPS = 1e-6
ROPE_THETA = 10000.0
MAX_STREAM_OFFSET_CHUNKS = 512

DA_HEADS = 8
DA_HEAD_DIM = 64
DA_QK_WIDTH = DA_HEADS * 2 * DA_HEAD_DIM
DA_V_DIM = 2 * DA_HEAD_DIM
DA_V_WIDTH = DA_HEADS * DA_V_DIM

MLA_HEADS = 8
MLA_Q_RANK = 384
MLA_KV_RANK = 256
MLA_NOPE_DIM = 128
MLA_ROPE_DIM = 64
MLA_V_DIM = 128
MLA_QK_DIM = MLA_NOPE_DIM + MLA_ROPE_DIM
MLA_V_WIDTH = MLA_HEADS * MLA_V_DIM

IN_SPLITS = (DA_QK_WIDTH, DA_QK_WIDTH, DA_V_WIDTH, MLA_Q_RANK, MLA_KV_RANK, MLA_ROPE_DIM,
             D_MODEL, D_MODEL)
IN_COLS = sum(IN_SPLITS)

D_FF = ((8 * D_MODEL // 3 + 255) // 256) * 256

kernel_name = "hybrid_diffattn_mla_gated_swiglu"


def rms_norm(x, w):
    xf = x.astype(jnp.float32)
    y = xf * lax.rsqrt(jnp.mean(xf * xf, axis=-1, keepdims=True) + RMS_EPS)
    return (y * w.astype(jnp.float32)).astype(x.dtype)


def rope(x, positions):
    d = x.shape[-1]
    half = d // 2
    inv_freq = 1.0 / (ROPE_THETA ** (jnp.arange(half, dtype=jnp.float32) * (2.0 / d)))
    ang = positions.astype(jnp.float32)[:, None, :, None] * inv_freq
    cos, sin = jnp.cos(ang), jnp.sin(ang)
    x1 = x[..., :half].astype(jnp.float32)
    x2 = x[..., half:].astype(jnp.float32)
    out = jnp.concatenate([x1 * cos - x2 * sin, x2 * cos + x1 * sin], axis=-1)
    return out.astype(x.dtype)


def split_heads(t, n_heads):
    b, s, w = t.shape
    return t.reshape(b, s, n_heads, w // n_heads).transpose(0, 2, 1, 3)


def merge_heads(t):
    b, h, s, d = t.shape
    return t.transpose(0, 2, 1, 3).reshape(b, s, h * d)


def chunk_causal_attention(q, k, v, scale):
    b, h, s, dk = q.shape
    dv = v.shape[-1]
    nb = s // Q_BLOCK
    q_blocks = q.reshape(b, h, nb, Q_BLOCK, dk).transpose(2, 0, 1, 3, 4)
    key_chunk = jnp.arange(s) // CHUNK

    def one_block(args):
        qi, i = args
        q_chunk = (i * Q_BLOCK + jnp.arange(Q_BLOCK)) // CHUNK
        mask = key_chunk[None, :] <= q_chunk[:, None]
        sc = jnp.einsum('bhqd,bhkd->bhqk', qi, k,
                        preferred_element_type=jnp.float32) * scale
        sc = jnp.where(mask, sc, jnp.float32(-1e30))
        p = jax.nn.softmax(sc, axis=-1).astype(v.dtype)
        return jnp.einsum('bhqk,bhkd->bhqd', p, v)

    out = lax.map(one_block, (q_blocks, jnp.arange(nb)))
    return out.transpose(1, 2, 0, 3, 4).reshape(b, h, s, dv)


def setup_inputs(seed: int = 0) -> dict:
    key = jax.random.key(seed)
    ks = jax.random.split(key, 32)

    def dense(k, shape):
        return jax.random.normal(k, (DEPTH,) + shape, jnp.float32) * (shape[0] ** -0.5)

    def gain(k, n):
        return 1.0 + 0.05 * jax.random.normal(k, (DEPTH, n), jnp.float32)

    x = jax.random.normal(ks[0], (BATCH, SEQ, D_MODEL), jnp.float32)
    offsets = jax.random.randint(ks[1], (BATCH, 1), 0, MAX_STREAM_OFFSET_CHUNKS) * CHUNK
    positions = (offsets + jnp.arange(SEQ, dtype=jnp.int32)[None, :]).astype(jnp.int32)

    return {
        "x": x,
        "positions": positions,
        "ln_mix_pre": gain(ks[2], D_MODEL),
        "w_in": dense(ks[3], (D_MODEL, IN_COLS)),
        "lambda_q1": 0.1 * jax.random.normal(ks[4], (DEPTH, DA_HEAD_DIM), jnp.float32),
        "lambda_k1": 0.1 * jax.random.normal(ks[5], (DEPTH, DA_HEAD_DIM), jnp.float32),
        "lambda_q2": 0.1 * jax.random.normal(ks[6], (DEPTH, DA_HEAD_DIM), jnp.float32),
        "lambda_k2": 0.1 * jax.random.normal(ks[7], (DEPTH, DA_HEAD_DIM), jnp.float32),
        "da_subln": gain(ks[8], DA_V_DIM),
        "q_a_norm": gain(ks[9], MLA_Q_RANK),
        "w_uq": dense(ks[10], (MLA_Q_RANK, MLA_HEADS * MLA_QK_DIM)),
        "kv_a_norm": gain(ks[11], MLA_KV_RANK),
        "w_ukv": dense(ks[12], (MLA_KV_RANK, MLA_HEADS * (MLA_NOPE_DIM + MLA_V_DIM))),
        "w_proj_a": dense(ks[13], (DA_V_WIDTH, D_MODEL)),
        "w_proj_b": dense(ks[14], (MLA_V_WIDTH, D_MODEL)),
        "w_o": dense(ks[15], (D_MODEL, D_MODEL)),
        "ln_mix_post": gain(ks[16], D_MODEL),
        "ln_ffn_pre": gain(ks[17], D_MODEL),
        "w_ffn_gate": dense(ks[18], (D_MODEL, D_FF)),
        "w_ffn_up": dense(ks[19], (D_MODEL, D_FF)),
        "w_ffn_down": dense(ks[20], (D_FF, D_MODEL)),
        "ln_ffn_post": gain(ks[21], D_MODEL),
    }


def reference(x, positions, ln_mix_pre, w_in, lambda_q1, lambda_k1, lambda_q2, lambda_k2,
              da_subln, q_a_norm, w_uq, kv_a_norm, w_ukv, w_proj_a, w_proj_b, w_o,
              ln_mix_post, ln_ffn_pre, w_ffn_gate, w_ffn_up, w_ffn_down, ln_ffn_post):
    bsz, seq, _ = x.shape
    offs = np.cumsum(IN_SPLITS)[:-1].tolist()
    for l in range(DEPTH):
        h = rms_norm(x, ln_mix_pre[l])
        z = h @ w_in[l]
        qa, ka, va, cq, ckv, k_rope, g_a, g_b = jnp.split(z, offs, axis=-1)

        lambda_init = 0.8 - 0.6 * math.exp(-0.3 * l)
        qa = split_heads(qa, DA_HEADS)
        ka = split_heads(ka, DA_HEADS)
        va = split_heads(va, DA_HEADS)
        q1 = rope(qa[..., :DA_HEAD_DIM], positions)
        q2 = rope(qa[..., DA_HEAD_DIM:], positions)
        k1 = rope(ka[..., :DA_HEAD_DIM], positions)
        k2 = rope(ka[..., DA_HEAD_DIM:], positions)
        da_scale = DA_HEAD_DIM ** -0.5
        o1 = chunk_causal_attention(q1, k1, va, da_scale)
        o2 = chunk_causal_attention(q2, k2, va, da_scale)
        lam = (jnp.exp(jnp.sum(lambda_q1[l].astype(jnp.float32) * lambda_k1[l].astype(jnp.float32)))
               - jnp.exp(jnp.sum(lambda_q2[l].astype(jnp.float32) * lambda_k2[l].astype(jnp.float32)))
               + lambda_init)
        oa = o1 - lam.astype(o1.dtype) * o2
        oa = rms_norm(oa, da_subln[l]) * (1.0 - lambda_init)
        y_a = merge_heads(oa) @ w_proj_a[l]

        cq = rms_norm(cq, q_a_norm[l])
        qb = split_heads(cq @ w_uq[l], MLA_HEADS)
        qb_nope = qb[..., :MLA_NOPE_DIM]
        qb_rope = rope(qb[..., MLA_NOPE_DIM:], positions)
        ckv = rms_norm(ckv, kv_a_norm[l])
        kv = split_heads(ckv @ w_ukv[l], MLA_HEADS)
        kb_nope = kv[..., :MLA_NOPE_DIM]
        vb = kv[..., MLA_NOPE_DIM:]
        kb_rope = rope(k_rope[:, None, :, :], positions)
        kb_rope = jnp.broadcast_to(kb_rope, (bsz, MLA_HEADS, seq, MLA_ROPE_DIM))
        qb_full = jnp.concatenate([qb_nope, qb_rope], axis=-1)
        kb_full = jnp.concatenate([kb_nope, kb_rope], axis=-1)
        ob = chunk_causal_attention(qb_full, kb_full, vb, MLA_QK_DIM ** -0.5)
        y_b = merge_heads(ob) @ w_proj_b[l]

        merged = jax.nn.sigmoid(g_a) * y_a + jax.nn.sigmoid(g_b) * y_b
        x = x + rms_norm(merged @ w_o[l], ln_mix_post[l])

        h = rms_norm(x, ln_ffn_pre[l])
        f = (jax.nn.silu(h @ w_ffn_gate[l]) * (h @ w_ffn_up[l])) @ w_ffn_down[l]
        x = x + rms_norm(f, ln_ffn_post[l])
    return x
```

```cpp
#include <hip/hip_runtime.h>
#include <hip/hip_cooperative_groups.h>
#include <cstdio>
#include <cstdint>
#include <cmath>
#include <cstring>
namespace cg = cooperative_groups;

#define LAS __attribute__((address_space(3)))
typedef unsigned short bf16_t;
typedef short bf16x8 __attribute__((ext_vector_type(8)));
typedef float f32x4 __attribute__((ext_vector_type(4)));
typedef float f32x16 __attribute__((ext_vector_type(16)));
typedef unsigned u32x4 __attribute__((ext_vector_type(4)));
typedef unsigned u32x2 __attribute__((ext_vector_type(2)));
typedef float f32x2_t __attribute__((ext_vector_type(2)));
typedef __bf16 bf16x2_t __attribute__((ext_vector_type(2)));

constexpr int BATCH = 4, SEQ = 8192, DM = 1024, T = BATCH * SEQ;
constexpr int DFF = 2816;
constexpr int IN_COLS = 5824;
constexpr int N1 = 4864;
constexpr float RMS_EPS = 1e-6f;
constexpr float LAMBDA_INIT = 0.2f;
constexpr int NTHR = 512;
constexpr float C2_DA = 0.125f * 1.4426950408889634f, C2_MLA = 0.07216878364870322f * 1.4426950408889634f;
constexpr int RP = 4;

constexpr size_t MiB = 1u << 20;
constexpr size_t WS_CTL = 0;
constexpr size_t WS_RSTDQ = 256 * 1024, WS_RSTDKV = 512 * 1024;
constexpr size_t WS_BAR = 64 * 1024, WS_BAR_BYTES = 16 * 1024;
constexpr size_t WS_W1T = 1 * MiB;
constexpr size_t WS_WVT = WS_W1T + (size_t)N1 * 1024 * 2;
constexpr size_t WS_WUQT = WS_WVT + (size_t)1024 * 1024 * 2;
constexpr size_t WS_WUKT = WS_WUQT + (size_t)1536 * 384 * 2;
constexpr size_t WS_WUVT = WS_WUKT + (size_t)1024 * 256 * 2;
constexpr size_t WS_WPAT = WS_WUVT + (size_t)1024 * 256 * 2;
constexpr size_t WS_WPBT = WS_WPAT + (size_t)1024 * 1024 * 2;
constexpr size_t WS_WOT = WS_WPBT + (size_t)1024 * 1024 * 2;
constexpr size_t WS_WGUT = WS_WOT + (size_t)1024 * 1024 * 2;
constexpr size_t WS_WDT = WS_WGUT + (size_t)5632 * 1024 * 2;
constexpr size_t WS_WEND = WS_WDT + (size_t)1024 * 2816 * 2;
static_assert(WS_WEND <= 38 * MiB, "weights");
constexpr size_t WS_TCOS = 38 * MiB, WS_TSIN = 42 * MiB;
constexpr size_t WS_QA = 46 * MiB, WS_KA = 110 * MiB, WS_GA = 174 * MiB, WS_GB = 238 * MiB, WS_VAT = 302 * MiB;
constexpr size_t WS_CQ = 366 * MiB, WS_CKV = 390 * MiB, WS_KR = 406 * MiB, WS_H = 410 * MiB, WS_QB = 410 * MiB;
constexpr size_t WS_END = 506 * MiB;
constexpr size_t WS_MERGED = WS_KA, WS_H2 = WS_QA, WS_U = WS_GA, WS_F = WS_QA, WS_T2 = WS_QB;
constexpr size_t OUT_KB = 0, OUT_VBT = 64 * MiB;

constexpr int LDS_BYTES = 135168;

__device__ __forceinline__ unsigned cvtpk(float lo, float hi) { f32x2_t v = {lo, hi}; bf16x2_t b = __builtin_convertvector(v, bf16x2_t); return __builtin_bit_cast(unsigned, b); }
__device__ __forceinline__ float bf2f(unsigned short u) { return __uint_as_float(((unsigned)u) << 16); }
__device__ __forceinline__ float bflo(unsigned u) { return __uint_as_float(u << 16); }
__device__ __forceinline__ float bfhi(unsigned u) { return __uint_as_float(u & 0xffff0000u); }
__device__ __forceinline__ float wave_sum(float v) {
#pragma unroll
    for (int o = 1; o < 64; o <<= 1) v += __shfl_xor(v, o);
    return v;
}
__device__ __forceinline__ float xhalf(float v) {
    return __shfl_xor(v, 32);
}
__device__ __forceinline__ float xhalf_max(float v) {
    auto rr = __builtin_amdgcn_permlane32_swap(__float_as_uint(v), __float_as_uint(v), false, false);
    return fmaxf(__uint_as_float(rr[0]), __uint_as_float(rr[1]));
}
__device__ __forceinline__ float xhalf_sum(float v) {
    auto rr = __builtin_amdgcn_permlane32_swap(__float_as_uint(v), __float_as_uint(v), false, false);
    return __uint_as_float(rr[0]) + __uint_as_float(rr[1]);
}
__device__ __forceinline__ void store8(bf16_t* p, f32x4 a, f32x4 b) {
    u32x4 w; w.x = cvtpk(a[0], a[1]); w.y = cvtpk(a[2], a[3]); w.z = cvtpk(b[0], b[1]); w.w = cvtpk(b[2], b[3]);
    *(u32x4*)p = w;
}

namespace pg8 {
constexpr int BM = 256, BK = 64, HALF = 128, HTB = HALF * BK * 2, STAGE_BYTES = 8 * HTB, NXCD = 8, WGM = 4;
__host__ __device__ __forceinline__ int lds_byte(int r, int c) { const int st = (r >> 4) * 2 + (c >> 5), rr = r & 15, cc = c & 31, ob = rr * 64 + cc * 2; return st * 1024 + (ob ^ (((ob >> 9) & 1) << 5)); }
__host__ __device__ __forceinline__ void stage_rc(int b, int& R, int& C) { const int st = b / 1024, sb = b % 1024, swz = sb ^ (((sb >> 9) & 1) << 5); R = (st >> 1) * 16 + swz / 64; C = (st & 1) * 32 + (swz % 64) / 2; }
__host__ __device__ __forceinline__ int perm32(int rho) { const int n = rho >> 4, i = rho & 15; return 8 * (i >> 2) + 4 * n + (i & 3); }

struct Unit { int pm, pn; };
struct Gemm { const bf16_t* A; const bf16_t* Bt; int M, N, K, lda, ldb; };

struct StaticOrder {
    int nM, nN, nwg, G, c, bal;
    __device__ void init(int M, int N, int G_, int c_, int bal_ = 0) { nM = M / BM; nN = N / BM; nwg = nM * nN; G = G_; c = c_; bal = bal_; }
    __device__ bool next(int i, Unit& u) const {
        long L;
        if (bal > 0) { if (c < bal) { if (i > 0) return false; L = c; } else { if (i > 2) return false; L = bal + 3 * (c - bal) + i; } }
        else L = (long)i * G + c;
        if (L >= nwg) return false;
        int wgid = (int)L; { const int q = nwg / NXCD, r = nwg % NXCD, xcd = wgid % NXCD, off = wgid / NXCD; wgid = (xcd < r ? xcd * (q + 1) : r * (q + 1) + (xcd - r) * q) + off; }
        const int nig = WGM * nN, gid = wgid / nig, fm = gid * WGM, gsz = (nM - fm) < WGM ? (nM - fm) : WGM;
        u.pm = fm + ((wgid % nig) % gsz); u.pn = (wgid % nig) / gsz; return true;
    }
};

template <class Epi>
__device__ __forceinline__ void gemm_phase(LAS unsigned char* lds, const Gemm g, const StaticOrder& S, const Epi& E) {
    const int tid = threadIdx.x, wid = __builtin_amdgcn_readfirstlane(tid >> 6), lane = tid & 63, wr = wid >> 2, wc = wid & 3, fr = lane & 15, fq = lane >> 4;
    int K = g.K; asm volatile("" : "+s"(K)); const int nt = K / BK;
    unsigned voffA[2], voffB[2];
#pragma unroll
    for (int i = 0; i < 2; ++i) { int R, C; stage_rc(tid * 16 + i * 8192, R, C); const int Rb = (R & ~31) + perm32(R & 31);
        voffA[i] = (unsigned)(R * g.lda + C) * 2u; voffB[i] = (unsigned)(Rb * g.ldb + C) * 2u; }
    const size_t kstep = (size_t)(BK * 2);
    const size_t hstepA = (size_t)HALF * g.lda * 2, hstepB = (size_t)HALF * g.ldb * 2;
    const size_t tstepA = 2 * hstepA, tstepB = 2 * hstepB;
    const unsigned ldsw = (unsigned)wid * 1024u;
    const int aoff = lds_byte(wr * 64 + fr, fq * 8), boff = lds_byte(wc * 32 + fr, fq * 8);
#define PG8_SA(b, h) (((b) * 2 + (h)) * HTB)
#define PG8_SB(b, h) ((4 + (b) * 2 + (h)) * HTB)
#define PG8_STAGE(bufoff, gbase, voff) do { _Pragma("unroll") for (int _i = 0; _i < 2; ++_i) \
        __builtin_amdgcn_global_load_lds((const unsigned*)((const char*)(gbase) + (voff)[_i]), (LAS unsigned*)(lds + (bufoff) + ldsw + _i * 8192), 16, 0, 0); } while (0)
#define PG8_LDA(dst, b, h) do { _Pragma("unroll") for (int m = 0; m < 4; ++m) _Pragma("unroll") for (int k = 0; k < 2; ++k) dst[m][k] = *(const LAS bf16x8*)(lds + PG8_SA(b, h) + aoff + m * 2048 + k * 1024); } while (0)
#define PG8_LDB(dst, b, h) do { _Pragma("unroll") for (int n = 0; n < 2; ++n) _Pragma("unroll") for (int k = 0; k < 2; ++k) dst[n][k] = *(const LAS bf16x8*)(lds + PG8_SB(b, h) + boff + n * 2048 + k * 1024); } while (0)
#define PG8_MMA(ai, bj, At, Bt) do { __builtin_amdgcn_s_setprio(1); _Pragma("unroll") for (int m = 0; m < 4; ++m) _Pragma("unroll") for (int n = 0; n < 2; ++n) _Pragma("unroll") for (int k = 0; k < 2; ++k) \
        acc[ai][bj][m][n] = __builtin_amdgcn_mfma_f32_16x16x32_bf16(Bt[n][k], At[m][k], acc[ai][bj][m][n], 0, 0, 0); __builtin_amdgcn_s_setprio(0); } while (0)
#define PG8_WAIT_V(n) asm volatile("s_waitcnt vmcnt(" #n ")" ::: "memory")
#define PG8_WAIT_L(n) asm volatile("s_waitcnt lgkmcnt(" #n ")" ::: "memory")
#define PG8_BAR __builtin_amdgcn_s_barrier()
#define PG8_SCHED __builtin_amdgcn_sched_barrier(0)
    Unit cur, nxt; int ui = 0;
    if (!S.next(0, cur)) return;
    f32x4 acc[2][2][4][2];
#pragma unroll
    for (int a = 0; a < 2; ++a)
#pragma unroll
        for (int b = 0; b < 2; ++b)
#pragma unroll
            for (int m = 0; m < 4; ++m)
#pragma unroll
                for (int n = 0; n < 2; ++n) acc[a][b][m][n] = (f32x4){0.f, 0.f, 0.f, 0.f};
    bf16x8 At[4][2], B0[2][2], B1[2][2];
    const char* cA = (const char*)g.A + (size_t)cur.pm * tstepA; const char* cB = (const char*)g.Bt + (size_t)cur.pn * tstepB;
    PG8_STAGE(PG8_SB(0, 0), cB, voffB); PG8_STAGE(PG8_SB(0, 1), cB + hstepB, voffB); PG8_STAGE(PG8_SA(0, 0), cA, voffA); PG8_STAGE(PG8_SA(0, 1), cA + hstepA, voffA);
    if (wr == 1) PG8_BAR;
    PG8_WAIT_V(2); PG8_BAR;
    PG8_STAGE(PG8_SB(1, 0), cB + kstep, voffB); PG8_STAGE(PG8_SA(1, 0), cA + kstep, voffA); PG8_STAGE(PG8_SB(1, 1), cB + hstepB + kstep, voffB);
    PG8_WAIT_V(6); PG8_BAR;
    for (;;) {
        const bool has_next = S.next(ui + 1, nxt);
        const char* nA = has_next ? (const char*)g.A + (size_t)nxt.pm * tstepA : cA; const char* nB = has_next ? (const char*)g.Bt + (size_t)nxt.pn * tstepB : cB;
#pragma unroll 1
        for (int t = 0; t < nt; t += 2) {
            const bool last = (t == nt - 2);
            const char* a1 = cA + (size_t)(t + 1) * kstep;
            const char* a2 = last ? nA : cA + (size_t)(t + 2) * kstep; const char* b2 = last ? nB : cB + (size_t)(t + 2) * kstep;
            const char* a3 = a2 + kstep; const char* b3 = b2 + kstep;
            PG8_LDB(B0, 0, 0); PG8_LDB(B1, 0, 1); PG8_SCHED; PG8_LDA(At, 0, 0); PG8_STAGE(PG8_SA(1, 1), a1 + hstepA, voffA);
            PG8_WAIT_V(8); PG8_WAIT_L(0); PG8_BAR; PG8_MMA(0, 0, At, B0); PG8_MMA(0, 1, At, B1); PG8_BAR; PG8_SCHED;
            PG8_LDA(At, 0, 1); PG8_STAGE(PG8_SB(0, 0), b2, voffB); PG8_STAGE(PG8_SB(0, 1), b2 + hstepB, voffB); PG8_STAGE(PG8_SA(0, 0), a2, voffA);
            PG8_WAIT_V(8); PG8_WAIT_L(0); PG8_BAR; PG8_MMA(1, 0, At, B0); PG8_MMA(1, 1, At, B1); PG8_BAR; PG8_SCHED;
            PG8_LDB(B0, 1, 0); PG8_LDB(B1, 1, 1); PG8_SCHED; PG8_LDA(At, 1, 0); PG8_STAGE(PG8_SA(0, 1), a2 + hstepA, voffA);
            PG8_WAIT_V(8); PG8_WAIT_L(0); PG8_BAR; PG8_MMA(0, 0, At, B0); PG8_MMA(0, 1, At, B1); PG8_BAR; PG8_SCHED;
            PG8_LDA(At, 1, 1); PG8_STAGE(PG8_SB(1, 0), b3, voffB); PG8_STAGE(PG8_SB(1, 1), b3 + hstepB, voffB); PG8_STAGE(PG8_SA(1, 0), a3, voffA);
            PG8_WAIT_V(8); PG8_WAIT_L(0); PG8_BAR; PG8_MMA(1, 0, At, B0); PG8_MMA(1, 1, At, B1); PG8_BAR; PG8_SCHED;
        }
        if (wr == 0) PG8_BAR;
        E(acc, cur, wr, wc, fr, fq);
        if (!has_next) break;
#pragma unroll
        for (int a = 0; a < 2; ++a)
#pragma unroll
            for (int b = 0; b < 2; ++b)
#pragma unroll
                for (int m = 0; m < 4; ++m)
#pragma unroll
                    for (int n = 0; n < 2; ++n) acc[a][b][m][n] = (f32x4){0.f, 0.f, 0.f, 0.f};
        cur = nxt; cA = nA; cB = nB; ++ui;
        if (wr == 1) PG8_BAR;
    }
    PG8_WAIT_V(0);
    PG8_BAR;
#undef PG8_SA
#undef PG8_SB
#undef PG8_STAGE
#undef PG8_LDA
#undef PG8_LDB
#undef PG8_MMA
#undef PG8_WAIT_V
#undef PG8_WAIT_L
#undef PG8_BAR
#undef PG8_SCHED
}
}

typedef f32x4 Acc[2][2][4][2];
using pg8::Unit;

struct EpiG1 {
    bf16_t *Qa, *Ka, *Ga, *Gb, *cq, *ckv, *kr; const float *tcos, *tsin;
    __device__ __forceinline__ void operator()(const Acc& acc, const Unit& u, int wr, int wc, int fr, int fq) const {
        const int pn = u.pn, row0 = u.pm * 256 + wr * 64 + fr;
        if (pn < 8) {
            bf16_t* dst = pn < 4 ? Qa : Ka; const int colbase = (pn & 3) * 256 + wc * 64 + 8 * fq;
            const float qs = pn < 4 ? C2_DA : 1.f;
            f32x4 tc[2][2], ts[2][2];
            { const size_t r = (size_t)row0; tc[0][0] = *(const f32x4*)(tcos + r * 32 + 8 * fq); tc[0][1] = *(const f32x4*)(tcos + r * 32 + 8 * fq + 4);
              ts[0][0] = *(const f32x4*)(tsin + r * 32 + 8 * fq); ts[0][1] = *(const f32x4*)(tsin + r * 32 + 8 * fq + 4); }
#pragma unroll
            for (int it = 0; it < 8; ++it) {
                const int ai = it >> 2, m = it & 3;
                const size_t r = (size_t)(row0 + ai * 128 + m * 16);
                if (it + 1 < 8) { const size_t rn = (size_t)(row0 + ((it + 1) >> 2) * 128 + ((it + 1) & 3) * 16);
                    tc[(it + 1) & 1][0] = *(const f32x4*)(tcos + rn * 32 + 8 * fq); tc[(it + 1) & 1][1] = *(const f32x4*)(tcos + rn * 32 + 8 * fq + 4);
                    ts[(it + 1) & 1][0] = *(const f32x4*)(tsin + rn * 32 + 8 * fq); ts[(it + 1) & 1][1] = *(const f32x4*)(tsin + rn * 32 + 8 * fq + 4); }
                const f32x4 c0 = tc[it & 1][0], c1 = tc[it & 1][1], s0 = ts[it & 1][0], s1 = ts[it & 1][1];
                const f32x4 a0 = acc[ai][0][m][0], a1 = acc[ai][0][m][1], b0 = acc[ai][1][m][0], b1 = acc[ai][1][m][1];
                store8(dst + r * 1024 + colbase, (a0 * c0 - b0 * s0) * qs, (a1 * c1 - b1 * s1) * qs);
                store8(dst + r * 1024 + colbase + 32, (b0 * c0 + a0 * s0) * qs, (b1 * c1 + a1 * s1) * qs);
                asm volatile("" ::: "memory");
            }
        } else if (pn < 16) {
            bf16_t* dst = pn < 12 ? Ga : Gb; const int colbase = ((pn - 8) & 3) * 256 + wc * 32 + 8 * fq;
#pragma unroll
            for (int ai = 0; ai < 2; ++ai)
#pragma unroll
                for (int m = 0; m < 4; ++m) {
                    const size_t r = (size_t)(row0 + ai * 128 + m * 16);
#pragma unroll
                    for (int bj = 0; bj < 2; ++bj) {
                        f32x4 v0 = acc[ai][bj][m][0], v1 = acc[ai][bj][m][1];
#pragma unroll
                        for (int e = 0; e < 4; ++e) { v0[e] = __builtin_amdgcn_rcpf(1.f + __builtin_amdgcn_exp2f(v0[e] * -1.4426950408889634f)); v1[e] = __builtin_amdgcn_rcpf(1.f + __builtin_amdgcn_exp2f(v1[e] * -1.4426950408889634f)); }
                        store8(dst + r * 1024 + colbase + bj * 128, v0, v1);
                    }
                }
        } else {
#pragma unroll
            for (int bj = 0; bj < 2; ++bj) {
                const int hidx = 2 * (pn - 16) + bj;
                bf16_t* dst; int ld, col;
                if (hidx < 3) { dst = cq; ld = 384; col = hidx * 128 + wc * 32 + 8 * fq; }
                else if (hidx < 5) { dst = ckv; ld = 256; col = (hidx - 3) * 128 + wc * 32 + 8 * fq; }
                else { dst = kr; ld = 64; col = wc * 32 + 8 * fq; if (wc >= 2) continue; }
#pragma unroll
                for (int ai = 0; ai < 2; ++ai)
#pragma unroll
                    for (int m = 0; m < 4; ++m) {
                        const size_t r = (size_t)(row0 + ai * 128 + m * 16);
                        store8(dst + r * ld + col, acc[ai][bj][m][0], acc[ai][bj][m][1]);
                    }
            }
        }
    }
};
template <bool RS, bool CS> struct EpiBf16 {
    bf16_t* O; int ld; const float* rs; const float* cs;
    __device__ __forceinline__ void operator()(const Acc& acc, const Unit& u, int wr, int wc, int fr, int fq) const {
        const int row0 = u.pm * 256 + wr * 64 + fr, col0 = u.pn * 256 + wc * 32 + 8 * fq;
        float rsv[8];
#pragma unroll
        for (int it = 0; it < 8; ++it) rsv[it] = RS ? rs[row0 + (it >> 2) * 128 + (it & 3) * 16] : 1.f;
#pragma unroll
        for (int bj = 0; bj < 2; ++bj) {
            f32x4 cv0 = (f32x4){1.f, 1.f, 1.f, 1.f}, cv1 = cv0;
            if (CS) { cv0 = *(const f32x4*)(cs + col0 + bj * 128); cv1 = *(const f32x4*)(cs + col0 + bj * 128 + 4); }
#pragma unroll
            for (int ai = 0; ai < 2; ++ai)
#pragma unroll
                for (int m = 0; m < 4; ++m) {
                    const size_t r = (size_t)(row0 + ai * 128 + m * 16);
                    f32x4 v0 = acc[ai][bj][m][0], v1 = acc[ai][bj][m][1];
                    if (CS) { v0 = v0 * cv0; v1 = v1 * cv1; }
                    if (RS) { const float sc = rsv[ai * 4 + m]; v0 = v0 * sc; v1 = v1 * sc; }
                    store8(O + r * ld + col0 + bj * 128, v0, v1);
                    asm volatile("" ::: "memory");
                }
        }
    }
};
struct EpiQb {
    bf16_t* Qb; const float* rs; const float *tcos, *tsin;
    __device__ __forceinline__ void operator()(const Acc& acc, const Unit& u, int wr, int wc, int fr, int fq) const {
        const int pn = u.pn, row0 = u.pm * 256 + wr * 64 + fr;
        float rsv[8];
#pragma unroll
        for (int it = 0; it < 8; ++it) rsv[it] = rs[row0 + (it >> 2) * 128 + (it & 3) * 16] * C2_MLA;
        if (pn < 4) {
#pragma unroll
            for (int it = 0; it < 8; ++it) {
                const int ai = it >> 2, m = it & 3; const size_t r = (size_t)(row0 + ai * 128 + m * 16); const float sc = rsv[it];
#pragma unroll
                for (int bj = 0; bj < 2; ++bj)
                    store8(Qb + r * 1536 + pn * 256 + bj * 128 + wc * 32 + 8 * fq, acc[ai][bj][m][0] * sc, acc[ai][bj][m][1] * sc);
                asm volatile("" ::: "memory");
            }
        } else {
            const int colbase = 1024 + (4 * (pn - 4) + wc) * 64 + 8 * fq;
            f32x4 tc[2][2], ts[2][2];
            { const size_t r = (size_t)row0; tc[0][0] = *(const f32x4*)(tcos + r * 32 + 8 * fq); tc[0][1] = *(const f32x4*)(tcos + r * 32 + 8 * fq + 4);
              ts[0][0] = *(const f32x4*)(tsin + r * 32 + 8 * fq); ts[0][1] = *(const f32x4*)(tsin + r * 32 + 8 * fq + 4); }
#pragma unroll
            for (int it = 0; it < 8; ++it) {
                const int ai = it >> 2, m = it & 3; const size_t r = (size_t)(row0 + ai * 128 + m * 16); const float sc = rsv[it];
                if (it + 1 < 8) { const size_t rn = (size_t)(row0 + ((it + 1) >> 2) * 128 + ((it + 1) & 3) * 16);
                    tc[(it + 1) & 1][0] = *(const f32x4*)(tcos + rn * 32 + 8 * fq); tc[(it + 1) & 1][1] = *(const f32x4*)(tcos + rn * 32 + 8 * fq + 4);
                    ts[(it + 1) & 1][0] = *(const f32x4*)(tsin + rn * 32 + 8 * fq); ts[(it + 1) & 1][1] = *(const f32x4*)(tsin + rn * 32 + 8 * fq + 4); }
                const f32x4 c0 = tc[it & 1][0], c1 = tc[it & 1][1], s0 = ts[it & 1][0], s1 = ts[it & 1][1];
                const f32x4 a0 = acc[ai][0][m][0] * sc, a1 = acc[ai][0][m][1] * sc, b0 = acc[ai][1][m][0] * sc, b1 = acc[ai][1][m][1] * sc;
                store8(Qb + r * 1536 + colbase, a0 * c0 - b0 * s0, a1 * c1 - b1 * s1);
                store8(Qb + r * 1536 + colbase + 32, b0 * c0 + a0 * s0, b1 * c1 + a1 * s1);
                asm volatile("" ::: "memory");
            }
        }
    }
};
template <int MODE> struct EpiMix {
    const bf16_t* G; const bf16_t* T1; bf16_t* O;
    __device__ __forceinline__ void operator()(const Acc& acc, const Unit& u, int wr, int wc, int fr, int fq) const {
        const int row0 = u.pm * 256 + wr * 64 + fr, col0 = u.pn * 256 + wc * 32 + 8 * fq;
#pragma unroll
        for (int ai = 0; ai < 2; ++ai) {
            u32x4 gw[4][2], tw[4][2];
            if (MODE != 2) {
#pragma unroll
                for (int m = 0; m < 4; ++m)
#pragma unroll
                    for (int bj = 0; bj < 2; ++bj) { const size_t off = (size_t)(row0 + ai * 128 + m * 16) * 1024 + col0 + bj * 128;
                        gw[m][bj] = *(const u32x4*)(G + off); if (MODE == 1) tw[m][bj] = *(const u32x4*)(T1 + off); }
            }
#pragma unroll
            for (int m = 0; m < 4; ++m) {
                const size_t r = (size_t)(row0 + ai * 128 + m * 16);
#pragma unroll
                for (int bj = 0; bj < 2; ++bj) {
                    const size_t off = r * 1024 + col0 + bj * 128;
                    f32x4 v0 = acc[ai][bj][m][0], v1 = acc[ai][bj][m][1];
                    if (MODE != 2) {
                        const u32x4 g = gw[m][bj];
                        v0 = v0 * (f32x4){bflo(g.x), bfhi(g.x), bflo(g.y), bfhi(g.y)};
                        v1 = v1 * (f32x4){bflo(g.z), bfhi(g.z), bflo(g.w), bfhi(g.w)};
                    }
                    if (MODE == 1) {
                        const u32x4 t = tw[m][bj];
                        v0 = v0 + (f32x4){bflo(t.x), bfhi(t.x), bflo(t.y), bfhi(t.y)};
                        v1 = v1 + (f32x4){bflo(t.z), bfhi(t.z), bflo(t.w), bfhi(t.w)};
                    }
                    store8(O + off, v0, v1);
                }
            }
            asm volatile("" ::: "memory");
        }
    }
};
struct EpiSwiglu {
    bf16_t* U;
    __device__ __forceinline__ void operator()(const Acc& acc, const Unit& u, int wr, int wc, int fr, int fq) const {
        const int row0 = u.pm * 256 + wr * 64 + fr, col0 = u.pn * 128 + wc * 32 + 8 * fq;
#pragma unroll
        for (int ai = 0; ai < 2; ++ai)
#pragma unroll
            for (int m = 0; m < 4; ++m) {
                const size_t r = (size_t)(row0 + ai * 128 + m * 16);
                f32x4 g0 = acc[ai][0][m][0], g1 = acc[ai][0][m][1];
                const f32x4 u0 = acc[ai][1][m][0], u1 = acc[ai][1][m][1];
#pragma unroll
                for (int e = 0; e < 4; ++e) { g0[e] = g0[e] * __builtin_amdgcn_rcpf(1.f + __builtin_amdgcn_exp2f(g0[e] * -1.4426950408889634f)); g1[e] = g1[e] * __builtin_amdgcn_rcpf(1.f + __builtin_amdgcn_exp2f(g1[e] * -1.4426950408889634f)); }
                store8(U + r * DFF + col0, g0 * u0, g1 * u1);
            }
    }
};

struct Args {
    const float* x; const int* pos; const float* ln_mix_pre; const float* w_in;
    const float *lq1, *lk1, *lq2, *lk2; const float* da_subln; const float* q_a_norm; const float* w_uq; const float* kv_a_norm; const float* w_ukv;
    const float *w_pa, *w_pb, *w_o; const float *ln_mix_post, *ln_ffn_pre; const float *w_g, *w_u, *w_d; const float* ln_ffn_post;
    float* out; unsigned char* ws;
    double invf[32];
    int ph_lo, ph_hi;
};

__device__ __forceinline__ void transpose_item(const float* src, int ldsrc, const float* gain, bf16_t* dst, int K, int k0, int n0, LAS float* scr, int lane) {
    if (src) {
#pragma unroll
        for (int i = 0; i < 32; ++i) { const int kk = 2 * i + (lane >> 5); float v = src[(size_t)(k0 + kk) * ldsrc + (lane & 31)]; if (gain) v *= gain[k0 + kk]; scr[kk * 33 + (lane & 31)] = v; }
    } else {
#pragma unroll 8
        for (int i = 0; i < 32; ++i) { const int kk = 2 * i + (lane >> 5); scr[kk * 33 + (lane & 31)] = 0.f; }
    }
    asm volatile("s_waitcnt lgkmcnt(0)" ::: "memory");
    const int c = lane & 7;
#pragma unroll
    for (int j = 0; j < 4; ++j) { const int n = (lane >> 3) + 8 * j; const LAS float* s = scr + (8 * c) * 33 + n;
        u32x4 o; o.x = cvtpk(s[0 * 33], s[1 * 33]); o.y = cvtpk(s[2 * 33], s[3 * 33]); o.z = cvtpk(s[4 * 33], s[5 * 33]); o.w = cvtpk(s[6 * 33], s[7 * 33]);
        *(u32x4*)(dst + (size_t)(n0 + n) * K + k0 + 8 * c) = o; }
    asm volatile("s_waitcnt lgkmcnt(0)" ::: "memory");
}

__device__ __forceinline__ void phase0(const Args& a, LAS unsigned char* lds, int vcu, int G) {
    const int tid = threadIdx.x, lane = tid & 63, wave = __builtin_amdgcn_readfirstlane(tid >> 6);
    LAS float* scr = (LAS float*)(lds + wave * 16384);
    const int gw = vcu * 8 + wave, NGW = G * 8;
    unsigned char* ws = a.ws;
    constexpr int I_W1 = 16 * (N1 / 32), I_WV = 16 * 32, I_UQ = 6 * 48, I_UK = 4 * 32, I_UV = 4 * 32, I_SQ = 16 * 32, I_GU = 16 * 176, I_D = 44 * 32;
    constexpr int NITEMS = I_W1 + I_WV + I_UQ + I_UK + I_UV + 3 * I_SQ + I_GU + I_D;
    for (int it = gw; it < NITEMS; it += NGW) {
        int r = it;
        if (r < I_W1) {
            const int nb = r % (N1 / 32), kb = r / (N1 / 32), n0 = nb * 32; int sc;
            if (n0 < 2048) { const int base = n0 < 1024 ? 0 : 1024, q = n0 & 1023, t = q >> 8, j = q & 255, bj = j >> 7, p = j & 127, sh = p >> 5; sc = base + 256 * t + 64 * sh + 32 * bj; }
            else if (n0 < 3072) sc = 3776 + (n0 - 2048);
            else if (n0 < 4096) sc = 4800 + (n0 - 3072);
            else if (n0 < 4480) sc = 3072 + (n0 - 4096);
            else if (n0 < 4736) sc = 3456 + (n0 - 4480);
            else if (n0 < 4800) sc = 3712 + (n0 - 4736);
            else sc = -1;
            transpose_item(sc >= 0 ? a.w_in + sc : nullptr, IN_COLS, nullptr, (bf16_t*)(ws + WS_W1T), 1024, kb * 64, n0, scr, lane); continue; }
        r -= I_W1;
        if (r < I_WV) { const int nb = r % 32, kb = r / 32; transpose_item(a.w_in + 2048 + nb * 32, IN_COLS, nullptr, (bf16_t*)(ws + WS_WVT), 1024, kb * 64, nb * 32, scr, lane); continue; }
        r -= I_WV;
        if (r < I_UQ) { const int nb = r % 48, kb = r / 48, n0 = nb * 32; int sc;
            if (n0 < 1024) sc = (n0 >> 7) * 192 + (n0 & 127);
            else { const int q = n0 - 1024, tt = q >> 8, j = q & 255, bj = j >> 7, p = j & 127, hh = p >> 5; sc = (4 * tt + hh) * 192 + 128 + 32 * bj; }
            transpose_item(a.w_uq + sc, 1536, a.q_a_norm, (bf16_t*)(ws + WS_WUQT), 384, kb * 64, n0, scr, lane); continue; }
        r -= I_UQ;
        if (r < I_UK) { const int nb = r % 32, kb = r / 32, n0 = nb * 32; transpose_item(a.w_ukv + (n0 >> 7) * 256 + (n0 & 127), 2048, a.kv_a_norm, (bf16_t*)(ws + WS_WUKT), 256, kb * 64, n0, scr, lane); continue; }
        r -= I_UK;
        if (r < I_UV) { const int nb = r % 32, kb = r / 32, n0 = nb * 32; transpose_item(a.w_ukv + (n0 >> 7) * 256 + 128 + (n0 & 127), 2048, a.kv_a_norm, (bf16_t*)(ws + WS_WUVT), 256, kb * 64, n0, scr, lane); continue; }
        r -= I_UV;
        if (r < 3 * I_SQ) { const int w = r / I_SQ, q = r % I_SQ, nb = q % 32, kb = q / 32;
            const float* src = w == 0 ? a.w_pa : (w == 1 ? a.w_pb : a.w_o); bf16_t* dst = (bf16_t*)(ws + (w == 0 ? WS_WPAT : (w == 1 ? WS_WPBT : WS_WOT)));
            transpose_item(src + nb * 32, 1024, nullptr, dst, 1024, kb * 64, nb * 32, scr, lane); continue; }
        r -= 3 * I_SQ;
        if (r < I_GU) { const int nb = r % 176, kb = r / 176, n0 = nb * 32, t = n0 >> 8, j = n0 & 255, bj = j >> 7, p = j & 127;
            transpose_item((bj ? a.w_u : a.w_g) + 128 * t + p, DFF, nullptr, (bf16_t*)(ws + WS_WGUT), 1024, kb * 64, n0, scr, lane); continue; }
        r -= I_GU;
        { const int nb = r % 32, kb = r / 32; transpose_item(a.w_d + nb * 32, 1024, nullptr, (bf16_t*)(ws + WS_WDT), DFF, kb * 64, nb * 32, scr, lane); }
    }
    {
        float* tcos = (float*)(ws + WS_TCOS); float* tsin = (float*)(ws + WS_TSIN);
        for (int e = vcu * NTHR + tid; e < T * 32; e += G * NTHR) {
            const int t = e >> 5, i = e & 31;
            const double ang = (double)a.pos[t] * a.invf[i];
            const double q = rint(ang * 0.63661977236758134308);
            double rr = fma(-q, 1.57079632679489655800e+00, ang); rr = fma(-q, 6.12323399573676603587e-17, rr);
            const double r2 = rr * rr;
            double sp = 1.0 / 6227020800.0; sp = fma(sp, r2, -1.0 / 39916800.0); sp = fma(sp, r2, 1.0 / 362880.0); sp = fma(sp, r2, -1.0 / 5040.0); sp = fma(sp, r2, 1.0 / 120.0); sp = fma(sp, r2, -1.0 / 6.0);
            const double sn = fma(rr * r2, sp, rr);
            double cp = -1.0 / 87178291200.0; cp = fma(cp, r2, 1.0 / 479001600.0); cp = fma(cp, r2, -1.0 / 3628800.0); cp = fma(cp, r2, 1.0 / 40320.0); cp = fma(cp, r2, -1.0 / 720.0); cp = fma(cp, r2, 1.0 / 24.0); cp = fma(cp, r2, -0.5);
            const double cs = fma(r2, cp, 1.0);
            const int qi = ((int)q) & 3;
            const double s_out = (qi == 0) ? sn : (qi == 1) ? cs : (qi == 2) ? -sn : -cs;
            const double c_out = (qi == 0) ? cs : (qi == 1) ? -sn : (qi == 2) ? -cs : sn;
            tcos[e] = (float)c_out; tsin[e] = (float)s_out;
        }
    }
    if (vcu == 0 && tid < 64) {
        const float d1 = wave_sum(a.lq1[lane] * a.lk1[lane]), d2 = wave_sum(a.lq2[lane] * a.lk2[lane]);
        if (lane == 0) ((float*)(ws + WS_CTL))[0] = expf(d1) - expf(d2) + LAMBDA_INIT;
    }
    {
        bf16_t* H = (bf16_t*)(ws + WS_H);
        for (int m0 = gw; m0 < T; m0 += RP * NGW) {
            f32x4 v[RP][4]; float sq[RP];
#pragma unroll
            for (int r = 0; r < RP; ++r) { const int m = m0 + r * NGW < T ? m0 + r * NGW : m0; const f32x4* xr = (const f32x4*)(a.x + (size_t)m * DM) + lane;
#pragma unroll
                for (int j = 0; j < 4; ++j) v[r][j] = xr[64 * j]; }
#pragma unroll
            for (int r = 0; r < RP; ++r) { float s = 0.f;
#pragma unroll
                for (int j = 0; j < 4; ++j) s += (v[r][j].x * v[r][j].x + v[r][j].y * v[r][j].y) + (v[r][j].z * v[r][j].z + v[r][j].w * v[r][j].w);
                sq[r] = s; }
#pragma unroll
            for (int r = 0; r < RP; ++r) { const int m = m0 + r * NGW; if (m >= T) break;
                const float rstd = 1.f / sqrtf(wave_sum(sq[r]) * (1.f / DM) + RMS_EPS);
                u32x2* o8 = (u32x2*)(H + (size_t)m * DM) + lane;
#pragma unroll
                for (int j = 0; j < 4; ++j) { const f32x4 g = ((const f32x4*)a.ln_mix_pre)[lane + 64 * j]; const f32x4 y = v[r][j] * rstd * g; u32x2 w; w.x = cvtpk(y.x, y.y); w.y = cvtpk(y.z, y.w); o8[64 * j] = w; } }
        }
    }
}

__device__ __forceinline__ void phase_mla_prep(const Args& a, int vcu, int G) {
    const int tid = threadIdx.x, lane = tid & 63, wave = __builtin_amdgcn_readfirstlane(tid >> 6);
    const int gw = vcu * 8 + wave, NGW = G * 8;
    unsigned char* ws = a.ws;
    const bf16_t* cq = (const bf16_t*)(ws + WS_CQ); const bf16_t* ckv = (const bf16_t*)(ws + WS_CKV); bf16_t* kr = (bf16_t*)(ws + WS_KR);
    float* rq = (float*)(ws + WS_RSTDQ); float* rkv = (float*)(ws + WS_RSTDKV);
    const float* tcos = (const float*)(ws + WS_TCOS); const float* tsin = (const float*)(ws + WS_TSIN);
    for (int m0 = gw * 4; m0 < T; m0 += NGW * 4) {
        unsigned wq[4][3], wk[4][2]; float x1[4], x2[4], cs[4], sn[4];
#pragma unroll
        for (int r = 0; r < 4; ++r) {
            const size_t m = (size_t)(m0 + r);
            const unsigned* p = (const unsigned*)(cq + m * 384); const unsigned* p2 = (const unsigned*)(ckv + m * 256);
#pragma unroll
            for (int j = 0; j < 3; ++j) wq[r][j] = p[lane + 64 * j];
#pragma unroll
            for (int j = 0; j < 2; ++j) wk[r][j] = p2[lane + 64 * j];
            x1[r] = bf2f(kr[m * 64 + (lane & 31)]); x2[r] = bf2f(kr[m * 64 + 32 + (lane & 31)]);
            cs[r] = tcos[m * 32 + (lane & 31)]; sn[r] = tsin[m * 32 + (lane & 31)];
        }
#pragma unroll
        for (int r = 0; r < 4; ++r) {
            const size_t m = (size_t)(m0 + r);
            float s = 0.f, s2 = 0.f;
#pragma unroll
            for (int j = 0; j < 3; ++j) { const float lo = bflo(wq[r][j]), hi = bfhi(wq[r][j]); s += lo * lo + hi * hi; }
#pragma unroll
            for (int j = 0; j < 2; ++j) { const float lo = bflo(wk[r][j]), hi = bfhi(wk[r][j]); s2 += lo * lo + hi * hi; }
            s = wave_sum(s); s2 = wave_sum(s2);
            if (lane == 0) { rq[m] = 1.f / sqrtf(s * (1.f / 384.f) + RMS_EPS); rkv[m] = 1.f / sqrtf(s2 * (1.f / 256.f) + RMS_EPS); }
            if (lane < 32) {
                const float y1 = x1[r] * cs[r] - x2[r] * sn[r], y2 = x2[r] * cs[r] + x1[r] * sn[r];
                kr[m * 64 + lane] = (bf16_t)(cvtpk(y1, 0.f) & 0xffffu); kr[m * 64 + 32 + lane] = (bf16_t)(cvtpk(y2, 0.f) & 0xffffu);
            }
        }
    }
}

__device__ __forceinline__ void phase_post_mix(const Args& a, int vcu, int G) {
    const int tid = threadIdx.x, lane = tid & 63, wave = __builtin_amdgcn_readfirstlane(tid >> 6);
    const int gw = vcu * 8 + wave, NGW = G * 8;
    bf16_t* H2 = (bf16_t*)(a.ws + WS_H2);
    for (int m0 = gw; m0 < T; m0 += RP * NGW) {
        f32x4 v[RP][4], xv[RP][4]; float sq[RP];
#pragma unroll
        for (int r = 0; r < RP; ++r) { const int m = m0 + r * NGW < T ? m0 + r * NGW : m0;
            const u32x2* t2r = (const u32x2*)((const bf16_t*)(a.ws + WS_T2) + (size_t)m * DM) + lane;
            const f32x4* xr = (const f32x4*)(a.x + (size_t)m * DM) + lane;
#pragma unroll
            for (int j = 0; j < 4; ++j) { const u32x2 w = t2r[64 * j]; v[r][j] = (f32x4){bflo(w.x), bfhi(w.x), bflo(w.y), bfhi(w.y)}; xv[r][j] = xr[64 * j]; } }
#pragma unroll
        for (int r = 0; r < RP; ++r) { float s = 0.f;
#pragma unroll
            for (int j = 0; j < 4; ++j) s += (v[r][j].x * v[r][j].x + v[r][j].y * v[r][j].y) + (v[r][j].z * v[r][j].z + v[r][j].w * v[r][j].w);
            sq[r] = wave_sum(s); }
#pragma unroll
        for (int r = 0; r < RP; ++r) { const int m = m0 + r * NGW; if (m >= T) break;
            const float rstd = 1.f / sqrtf(sq[r] * (1.f / DM) + RMS_EPS);
            if (lane == 0) ((float*)(a.ws + WS_RSTDQ))[m] = rstd;
            float s2 = 0.f;
#pragma unroll
            for (int j = 0; j < 4; ++j) { const f32x4 g = ((const f32x4*)a.ln_mix_post)[lane + 64 * j]; v[r][j] = xv[r][j] + v[r][j] * rstd * g;
                s2 += (v[r][j].x * v[r][j].x + v[r][j].y * v[r][j].y) + (v[r][j].z * v[r][j].z + v[r][j].w * v[r][j].w); }
            const float rstd2 = 1.f / sqrtf(wave_sum(s2) * (1.f / DM) + RMS_EPS);
            u32x2* o8 = (u32x2*)(H2 + (size_t)m * DM) + lane;
#pragma unroll
            for (int j = 0; j < 4; ++j) { const f32x4 g = ((const f32x4*)a.ln_ffn_pre)[lane + 64 * j]; const f32x4 y = v[r][j] * rstd2 * g; u32x2 w; w.x = cvtpk(y.x, y.y); w.y = cvtpk(y.z, y.w); o8[64 * j] = w; } }
    }
}
__device__ __forceinline__ void phase_final(const Args& a, int vcu, int G) {
    const int tid = threadIdx.x, lane = tid & 63, wave = __builtin_amdgcn_readfirstlane(tid >> 6);
    const int gw = vcu * 8 + wave, NGW = G * 8;
    const bf16_t* F = (const bf16_t*)(a.ws + WS_F); const bf16_t* T2 = (const bf16_t*)(a.ws + WS_T2); const float* R1 = (const float*)(a.ws + WS_RSTDQ);
    for (int m0 = gw; m0 < T; m0 += RP * NGW) {
        f32x4 v[RP][4], xv[RP][4]; float sq[RP];
#pragma unroll
        for (int r = 0; r < RP; ++r) { const int m = m0 + r * NGW < T ? m0 + r * NGW : m0;
            const u32x2* fr = (const u32x2*)(F + (size_t)m * DM) + lane; const u32x2* tr = (const u32x2*)(T2 + (size_t)m * DM) + lane;
            const f32x4* xr = (const f32x4*)(a.x + (size_t)m * DM) + lane; const float r1 = R1[m];
#pragma unroll
            for (int j = 0; j < 4; ++j) { const u32x2 w = fr[64 * j]; v[r][j] = (f32x4){bflo(w.x), bfhi(w.x), bflo(w.y), bfhi(w.y)};
                const u32x2 w2 = tr[64 * j]; const f32x4 t2v = (f32x4){bflo(w2.x), bfhi(w2.x), bflo(w2.y), bfhi(w2.y)};
                const f32x4 g1 = ((const f32x4*)a.ln_mix_post)[lane + 64 * j]; xv[r][j] = xr[64 * j] + t2v * r1 * g1; } }
#pragma unroll
        for (int r = 0; r < RP; ++r) { float s = 0.f;
#pragma unroll
            for (int j = 0; j < 4; ++j) s += (v[r][j].x * v[r][j].x + v[r][j].y * v[r][j].y) + (v[r][j].z * v[r][j].z + v[r][j].w * v[r][j].w);
            sq[r] = wave_sum(s); }
#pragma unroll
        for (int r = 0; r < RP; ++r) { const int m = m0 + r * NGW; if (m >= T) break;
            f32x4* orow = (f32x4*)(a.out + (size_t)m * DM) + lane;
            const float rstd = 1.f / sqrtf(sq[r] * (1.f / DM) + RMS_EPS);
#pragma unroll
            for (int j = 0; j < 4; ++j) { const f32x4 g = ((const f32x4*)a.ln_ffn_post)[lane + 64 * j]; orow[64 * j] = xv[r][j] + v[r][j] * rstd * g; } }
    }
}

#define MFMA32(a, b, c) __builtin_amdgcn_mfma_f32_32x32x16_bf16((a), (b), (c), 0, 0, 0)
template <int MODE>
__device__ __forceinline__ void attn_unit(LAS unsigned char* lds, const Args& a, int b, int h, int qb, bool desc) {
    constexpr int KB_ = 16384, RB_ = MODE == 1 ? 8192 : 0, VB_ = 16384, STAGE = KB_ + RB_ + VB_;
    constexpr int NK = MODE == 0 ? 4 : 12;
    constexpr int NI = MODE == 0 ? 4 : 5;
    constexpr int QROWS = MODE == 0 ? 128 : 256;
    int tid = threadIdx.x; asm volatile("" : "+v"(tid));
    const int lane = tid & 63, hi = lane >> 5, ql = lane & 31;
    const int wid = __builtin_amdgcn_readfirstlane(tid >> 6);
    const int grp = MODE == 0 ? (wid & 3) : wid, which = MODE == 0 ? (wid >> 2) : 0;
    const int q0 = qb * QROWS;
    const int cw = (q0 + grp * 32) >> 6;
    const int nt = (q0 + QROWS) >> 6;
    const size_t bS = (size_t)b * SEQ;
    const size_t tq = bS + q0 + grp * 32 + ql;
    unsigned char* ws = a.ws;
    const bf16_t* Ksrc = MODE == 0 ? (const bf16_t*)(ws + WS_KA) : (const bf16_t*)(a.out);
    const bf16_t* Vsrc = MODE == 0 ? (const bf16_t*)(ws + WS_VAT) : (const bf16_t*)((unsigned char*)a.out + OUT_VBT);
    const char* kbase = (const char*)(Ksrc + bS * 1024 + h * 128);
    const char* vbase = (const char*)(Vsrc + (size_t)(h * 128) * T + bS);
    const char* rbase = (const char*)((const bf16_t*)(ws + WS_KR) + bS * 64);
    unsigned kso[2], vso[2], rso;
#pragma unroll
    for (int j = 0; j < 2; ++j) {
        { const int row = 4 * (wid * 2 + j) + (lane >> 4), c = (lane & 15) ^ (row & 15); kso[j] = (unsigned)(row * 2048 + c * 16); }
        { const int row = 8 * (wid * 2 + j) + (lane >> 3), c = (lane & 7) ^ ((row >> 1) & 7); vso[j] = (unsigned)(row * (T * 2) + c * 16); }
    }
    { const int row = 8 * wid + (lane >> 3), c = (lane & 7) ^ ((row >> 1) & 7); rso = (unsigned)(row * 128 + c * 16); }
#define ATT_DMA(kt, buf) do { const char* kb_ = kbase + (size_t)(kt) * (64 * 1024 * 2); const char* vb_ = vbase + (size_t)(kt) * 128; LAS unsigned char* sb_ = lds + (buf) * STAGE; \
        _Pragma("unroll") for (int j = 0; j < 2; ++j) { \
            __builtin_amdgcn_global_load_lds((const unsigned*)(kb_ + kso[j]), (LAS unsigned*)(sb_ + (wid * 2 + j) * 1024), 16, 0, 0); \
            __builtin_amdgcn_global_load_lds((const unsigned*)(vb_ + vso[j]), (LAS unsigned*)(sb_ + KB_ + RB_ + (wid * 2 + j) * 1024), 16, 0, 0); } \
        if (MODE == 1) __builtin_amdgcn_global_load_lds((const unsigned*)(rbase + (size_t)(kt) * (64 * 64 * 2) + rso), (LAS unsigned*)(sb_ + KB_ + wid * 1024), 16, 0, 0); } while (0)
    asm volatile("s_waitcnt vmcnt(0)" ::: "memory"); __builtin_amdgcn_s_barrier();
    const bool dsc_ = (MODE == 0) && desc;
#define ATT_TILE(i) (dsc_ ? nt - 1 - (i) : (i))
    ATT_DMA(ATT_TILE(0), 0); ATT_DMA(ATT_TILE(1), 1);
    bf16x8 qf[NK];
    if (MODE == 0) {
        const bf16_t* Q = (const bf16_t*)(ws + WS_QA) + tq * 1024 + h * 128 + which * 64 + 8 * hi;
#pragma unroll
        for (int ks = 0; ks < 4; ++ks) qf[ks] = *(const bf16x8*)(Q + 16 * ks);
    } else {
        const bf16_t* Q = (const bf16_t*)(ws + WS_QB) + tq * 1536 + 8 * hi;
#pragma unroll
        for (int ks = 0; ks < 8; ++ks) qf[ks] = *(const bf16x8*)(Q + h * 128 + 16 * ks);
#pragma unroll
        for (int ks = 8; ks < 12; ++ks) qf[ks] = *(const bf16x8*)(Q + 1024 + h * 64 + 16 * (ks - 8));
    }
    const int g_ = ql >> 3, hb_ = (ql >> 2) & 1, j_ = ql & 3;
    const int pim = 16 * (g_ >> 1) + 8 * hb_ + 4 * (g_ & 1) + j_;
    unsigned kl[MODE == 0 ? 4 : 8], rl[4], vl[4];
#pragma unroll
    for (int ks = 0; ks < (MODE == 0 ? 4 : 8); ++ks) kl[ks] = (unsigned)(pim * 256 + ((((MODE == 0 ? which * 8 : 0) + 2 * ks + hi) ^ (pim & 15)) * 16));
#pragma unroll
    for (int ks = 0; ks < 4; ++ks) { rl[ks] = (unsigned)(KB_ + pim * 128 + (((2 * ks + hi) ^ ((pim >> 1) & 7)) * 16)); vl[ks] = (unsigned)(KB_ + RB_ + ql * 128 + (((2 * ks + hi) ^ ((ql >> 1) & 7)) * 16)); }
    f32x16 o[4];
#pragma unroll
    for (int d = 0; d < 4; ++d)
#pragma unroll
        for (int i = 0; i < 16; ++i) o[d][i] = 0.f;
    float mrun = 0.f, lrun = 0.f;
    f32x16 negm;
#pragma unroll
    for (int i = 0; i < 16; ++i) negm[i] = 0.f;
    asm volatile("s_waitcnt vmcnt(0)" ::: "memory"); __builtin_amdgcn_s_barrier();
    int bcur = 0, bnext2 = 2;
    for (int kt = 0; kt < nt; ++kt) {
        const int tile = ATT_TILE(kt);
        if (kt + 2 < nt) ATT_DMA(ATT_TILE(kt + 2), bnext2);
        if (tile <= cw) {
            const LAS unsigned char* base = lds + bcur * STAGE;
            f32x16 s0, s1;
            bf16x8 ka[2][2];
#define ATT_LDK(bf, ks) do { if ((ks) < (MODE == 0 ? 4 : 8)) { ka[bf][0] = *(const LAS bf16x8*)(base + kl[(ks) & 7]); ka[bf][1] = *(const LAS bf16x8*)(base + kl[(ks) & 7] + 32 * 256); } \
        else { ka[bf][0] = *(const LAS bf16x8*)(base + rl[(ks) & 3]); ka[bf][1] = *(const LAS bf16x8*)(base + rl[(ks) & 3] + 32 * 128); } } while (0)
            ATT_LDK(0, 0);
#pragma unroll
            for (int ks = 0; ks < NK; ++ks) {
                if (ks + 1 < NK) ATT_LDK((ks + 1) & 1, ks + 1);
                __builtin_amdgcn_sched_barrier(0);

                if (ks == 0) { s0 = MFMA32(ka[0][0], qf[0], negm); s1 = MFMA32(ka[0][1], qf[0], negm); }
                else { s0 = MFMA32(ka[ks & 1][0], qf[ks], s0); s1 = MFMA32(ka[ks & 1][1], qf[ks], s1); }

                __builtin_amdgcn_sched_barrier(0);
            }
#undef ATT_LDK
            bf16x8 va[2][4];
#define ATT_LDVK(bf, kk) do { _Pragma("unroll") for (int d = 0; d < 4; ++d) va[bf][d] = *(const LAS bf16x8*)(base + vl[kk] + d * 32 * 128); } while (0)
            ATT_LDVK(0, 0);
            float mx0 = fmaxf(s0[0], s0[1]), mx1 = fmaxf(s1[0], s1[1]);
#pragma unroll
            for (int i = 2; i < 16; i += 2) { mx0 = fmaxf(fmaxf(mx0, s0[i]), s0[i + 1]); mx1 = fmaxf(fmaxf(mx1, s1[i]), s1[i + 1]); }
            const float mxs = xhalf_max(fmaxf(mx0, mx1));
            const bool first_ = tile == (dsc_ ? cw : 0);
            if (first_ || __builtin_amdgcn_ballot_w64(mxs > 8.0f) != 0ull) {
                const float delta = first_ ? mxs : fmaxf(mxs, 0.f);
                const float alpha = first_ ? 1.f : __builtin_amdgcn_exp2f(-delta);
                mrun += delta; lrun *= alpha; s0 = s0 - delta; s1 = s1 - delta;
#pragma unroll
                for (int d = 0; d < 4; ++d) o[d] = o[d] * alpha;
#pragma unroll
                for (int i = 0; i < 16; ++i) negm[i] = -mrun;
            }
            __builtin_amdgcn_sched_barrier(0);
            bf16x8 p[4]; float psum;
#define ATT_SLICE(g, S, off) do { _Pragma("unroll") for (int i = 0; i < 8; ++i) S[(off) + i] = __builtin_amdgcn_exp2f(S[(off) + i]); \
        u32x4 w_; w_.x = cvtpk(S[(off)], S[(off) + 1]); w_.y = cvtpk(S[(off) + 2], S[(off) + 3]); w_.z = cvtpk(S[(off) + 4], S[(off) + 5]); w_.w = cvtpk(S[(off) + 6], S[(off) + 7]); p[g] = __builtin_bit_cast(bf16x8, w_); \
        const float t_ = ((S[(off)] + S[(off) + 1]) + (S[(off) + 2] + S[(off) + 3])) + ((S[(off) + 4] + S[(off) + 5]) + (S[(off) + 6] + S[(off) + 7])); if ((g) == 0) psum = t_; else psum += t_; } while (0)
            ATT_SLICE(0, s0, 0);
#pragma unroll
            for (int g = 0; g < 4; ++g) {
                if (g + 1 < 4) ATT_LDVK((g + 1) & 1, g + 1);
#pragma unroll
                for (int d = 0; d < 4; ++d) o[d] = MFMA32(va[g & 1][d], p[g], o[d]);
                if (g == 0) ATT_SLICE(1, s0, 8);
                if (g == 1) ATT_SLICE(2, s1, 0);
                if (g == 2) ATT_SLICE(3, s1, 8);
#pragma unroll
                for (int i = 0; i < 4; ++i) { __builtin_amdgcn_sched_group_barrier(0x008, 1, 0); __builtin_amdgcn_sched_group_barrier(0x100, 1, 0); __builtin_amdgcn_sched_group_barrier(0x002, 5, 0); }
            }
            __builtin_amdgcn_sched_barrier(0);
            lrun += psum;
#undef ATT_SLICE
#undef ATT_LDVK
        }
        if (kt + 2 < nt) { if (MODE == 0) asm volatile("s_waitcnt vmcnt(4)" ::: "memory"); else asm volatile("s_waitcnt vmcnt(5)" ::: "memory"); }
        else asm volatile("s_waitcnt vmcnt(0)" ::: "memory");
        __builtin_amdgcn_s_barrier();
        bcur = (bcur == 2) ? 0 : bcur + 1; bnext2 = (bnext2 == 2) ? 0 : bnext2 + 1;
    }
#undef ATT_DMA
#undef ATT_TILE
    lrun = xhalf_sum(lrun);
    const float inv = 1.f / lrun;
    if (MODE == 1) {
        bf16_t* O = (bf16_t*)(ws + WS_QB) + tq * 1536 + h * 128 + 4 * hi;
#pragma unroll
        for (int d = 0; d < 4; ++d)
#pragma unroll
            for (int g = 0; g < 4; ++g) {
                u32x2 w; w.x = cvtpk(o[d][4 * g] * inv, o[d][4 * g + 1] * inv); w.y = cvtpk(o[d][4 * g + 2] * inv, o[d][4 * g + 3] * inv);
                *(u32x2*)(O + 32 * d + 8 * g) = w;
            }
    } else {
        LAS float* X = (LAS float*)lds;
        const float lam = ((const float*)(ws + WS_CTL))[0];
        if (which == 1) {
#pragma unroll
            for (int d = 0; d < 4; ++d)
#pragma unroll
                for (int i = 0; i < 16; ++i) X[(d * 16 + i) * 256 + grp * 64 + lane] = o[d][i] * inv;
        }
        __syncthreads();
        if (which == 0) {
            float ssq = 0.f;
#pragma unroll
            for (int d = 0; d < 4; ++d)
#pragma unroll
                for (int i = 0; i < 16; ++i) { const float v = o[d][i] * inv - lam * X[(d * 16 + i) * 256 + grp * 64 + lane]; o[d][i] = v; ssq += v * v; }
            ssq = xhalf_sum(ssq);
            const float rstd = (1.f / sqrtf(ssq * (1.f / 128.f) + RMS_EPS)) * (1.f - LAMBDA_INIT);
            bf16_t* O = (bf16_t*)(ws + WS_QA) + tq * 1024 + h * 128 + 4 * hi;
#pragma unroll
            for (int d = 0; d < 4; ++d)
#pragma unroll
                for (int g = 0; g < 4; ++g) {
                    const f32x4 gn = *(const f32x4*)(a.da_subln + 32 * d + 8 * g + 4 * hi);
                    u32x2 w; w.x = cvtpk(o[d][4 * g] * rstd * gn.x, o[d][4 * g + 1] * rstd * gn.y); w.y = cvtpk(o[d][4 * g + 2] * rstd * gn.z, o[d][4 * g + 3] * rstd * gn.w);
                    *(u32x2*)(O + 32 * d + 8 * g) = w;
                }
        }
        __syncthreads();
    }
}

__device__ __forceinline__ void phase_attn(const Args& a, LAS unsigned char* lds, int vcu, int G) {
#pragma unroll 1
    for (int p2 = 2 * vcu; p2 < 2048; p2 += 2 * G) {
#pragma unroll 1
        for (int hf = 0; hf < 2; ++hf) {
            const int p = p2 >> 1, bh = p >> 5, pr = p & 31;
            attn_unit<0>(lds, a, bh >> 3, bh & 7, hf ? pr : 63 - pr, hf != 0);
        }
    }
    if (G == 256) {
        const int x = vcu >> 5, j = vcu & 31;
#pragma unroll 1
        for (int r = 0; r < 4; ++r) {
            const int bh = 4 * x + r;
            const int qb = (r & 1) ? (j < 16 ? j : 47 - j) : (j < 16 ? 31 - j : j - 16);
            attn_unit<1>(lds, a, bh >> 3, bh & 7, qb, (r & 1) != 0);
        }
    } else {
#pragma unroll 1
        for (int p2 = 2 * vcu; p2 < 1024; p2 += 2 * G) {
#pragma unroll 1
            for (int hf = 0; hf < 2; ++hf) {
                const int p = p2 >> 1, bh = p >> 4, pr = p & 15;
                attn_unit<1>(lds, a, bh >> 3, bh & 7, hf ? pr : 31 - pr, hf != 0);
            }
        }
    }
}

#define XB_TMO      128
#define XB_XCNT(j)  (256  + 64 * (j))
#define XB_XSUB(j)  (1280 + 64 * (j))
#define XB_XGEN(j)  (2304 + 64 * (j))
#define XB_TOP      3328
#define XB_TOPGEN   3392
#define XCD_BAR_WORDS 3456
#define XB_SPIN_CAP (1u << 22)
__device__ __forceinline__ unsigned xb_ld(unsigned* p)              { return __hip_atomic_load(p, __ATOMIC_RELAXED, __HIP_MEMORY_SCOPE_AGENT); }
__device__ __forceinline__ unsigned xb_add(unsigned* p, unsigned v) { return __hip_atomic_fetch_add(p, v, __ATOMIC_RELAXED, __HIP_MEMORY_SCOPE_AGENT); }
__device__ __forceinline__ unsigned xb_xcc_id() { return (unsigned)__builtin_amdgcn_s_getreg((3 << 11) | 20) & 0xFu; }
#define XB_SPIN(cond, bar) do { unsigned _sp = 0; while (cond) { __builtin_amdgcn_s_sleep(1); \
    if ((++_sp & 255u) == 0u) { if (xb_ld(&(bar)[XB_TMO])) break; if (_sp > XB_SPIN_CAP) { atomicAdd(&(bar)[XB_TMO], 1u); break; } } } } while (0)
struct XcdBarrier { unsigned* bar; unsigned x; volatile LAS unsigned* st; };
__device__ __forceinline__ XcdBarrier xcd_barrier_post(unsigned* bar, volatile LAS unsigned* st) {
    XcdBarrier b; b.bar = bar; b.x = xb_xcc_id(); b.st = st;
    if (threadIdx.x == 0) (void)xb_add(&bar[XB_XCNT(b.x)], 1u);
    return b;
}
__device__ __forceinline__ void xcd_barrier_complete(unsigned* bar, unsigned x, unsigned& nloc, unsigned& nx) {
    const unsigned G = gridDim.x * gridDim.y * gridDim.z;
    unsigned sum, cnt, mine, sp = 0u;
    for (;;) {
        sum = 0u; cnt = 0u; mine = 0u;
#pragma unroll
        for (unsigned j = 0; j < 16; ++j) { const unsigned c = xb_ld(&bar[XB_XCNT(j)]); sum += c; cnt += (c > 0u) ? 1u : 0u; mine = (j == x) ? c : mine; }
        if (sum == G) break;
        __builtin_amdgcn_s_sleep(1);
        if ((++sp & 255u) == 0u) { if (xb_ld(&bar[XB_TMO])) break; if (sp > XB_SPIN_CAP) { atomicAdd(&bar[XB_TMO], 1u); break; } }
    }
    nloc = mine > 0u ? mine : 1u; nx = cnt > 0u ? cnt : 1u;
}
__device__ __forceinline__ void xcd_barrier(const XcdBarrier& b) {
    asm volatile("s_waitcnt vmcnt(0)" ::: "memory");
    __syncthreads();
    if (threadIdx.x == 0) {
        unsigned* bar = b.bar;
        __builtin_amdgcn_s_waitcnt(0);
        unsigned nloc = b.st[0], nx = b.st[1];
        if (nloc == 0u) { xcd_barrier_complete(bar, b.x, nloc, nx); b.st[0] = nloc; b.st[1] = nx; }
        const unsigned old = xb_add(&bar[XB_XSUB(b.x)], 1u);
        const unsigned gen = old / nloc;
        if (old + 1u == (gen + 1u) * nloc) {
            __builtin_amdgcn_fence(__ATOMIC_RELEASE, "agent");
            asm volatile("s_waitcnt vmcnt(0)" ::: "memory");
            const unsigned og = xb_add(&bar[XB_TOP], 1u);
            const unsigned tg = og / nx;
            if (og + 1u == (tg + 1u) * nx) xb_add(&bar[XB_TOPGEN], 1u);
            else XB_SPIN(xb_ld(&bar[XB_TOPGEN]) == tg, bar);
            __builtin_amdgcn_fence(__ATOMIC_ACQUIRE, "agent");
            xb_add(&bar[XB_XGEN(b.x)], 1u);
            asm volatile("s_waitcnt vmcnt(0)" ::: "memory");
        } else {
            XB_SPIN(xb_ld(&bar[XB_XGEN(b.x)]) == gen, bar);
            __builtin_amdgcn_fence(__ATOMIC_ACQUIRE, "agent");
            asm volatile("s_waitcnt vmcnt(0)" ::: "memory");
        }
    }
    __syncthreads();
}

__global__ void __launch_bounds__(NTHR, 2) fwd_kernel(Args a) {
    extern __shared__ __attribute__((aligned(16))) unsigned char lds_raw[];
    LAS unsigned char* lds = (LAS unsigned char*)lds_raw;
    cg::grid_group grid = cg::this_grid();
    const int G = gridDim.x; const int bx = blockIdx.x;
    const int vcu = (G % 8 == 0) ? (bx % 8) * (G / 8) + bx / 8 : bx;
    unsigned char* ws = a.ws;
    const int lo = a.ph_lo, hi = a.ph_hi;
    volatile LAS unsigned* bst = (volatile LAS unsigned*)(lds + LDS_BYTES - 16);
    if (threadIdx.x < 4) bst[threadIdx.x] = 0u;
    __syncthreads();
    const XcdBarrier xbar = xcd_barrier_post((unsigned*)(ws + WS_BAR), bst);
#ifndef PHMASK
#define PHMASK 0xFFF
#endif
#define IN(k) (((PHMASK >> (k)) & 1) && lo <= (k) && (k) < hi)
#define SEAM(k) do { if (IN(k) && IN((k) + 1)) xcd_barrier(xbar); } while (0)
    if (lo < 0) grid.sync();
    bf16_t* Qa = (bf16_t*)(ws + WS_QA); bf16_t* Ka = (bf16_t*)(ws + WS_KA); bf16_t* Ga = (bf16_t*)(ws + WS_GA); bf16_t* Gb = (bf16_t*)(ws + WS_GB);
    bf16_t* VaT = (bf16_t*)(ws + WS_VAT); bf16_t* cq = (bf16_t*)(ws + WS_CQ); bf16_t* ckv = (bf16_t*)(ws + WS_CKV); bf16_t* kr = (bf16_t*)(ws + WS_KR);
    bf16_t* H = (bf16_t*)(ws + WS_H); bf16_t* Qb = (bf16_t*)(ws + WS_QB);
    bf16_t* Kb = (bf16_t*)((unsigned char*)a.out + OUT_KB); bf16_t* VbT = (bf16_t*)((unsigned char*)a.out + OUT_VBT);
    const float* tcos = (const float*)(ws + WS_TCOS); const float* tsin = (const float*)(ws + WS_TSIN);
    const float* rq = (const float*)(ws + WS_RSTDQ); const float* rkv = (const float*)(ws + WS_RSTDKV);
    pg8::StaticOrder S;

    if (IN(0)) { phase0(a, lds, vcu, G); __syncthreads(); }
    SEAM(0);
    if (IN(1)) {
        { pg8::Gemm g{H, (const bf16_t*)(ws + WS_W1T), T, N1, 1024, 1024, 1024}; S.init(T, N1, G, bx);
          EpiG1 E{Qa, Ka, Ga, Gb, cq, ckv, kr, tcos, tsin}; pg8::gemm_phase(lds, g, S, E); }
        { pg8::Gemm g{(const bf16_t*)(ws + WS_WVT), H, 1024, T, 1024, 1024, 1024}; S.init(1024, T, G, bx, G == 256 ? 128 : 0);
          EpiBf16<false, false> E{VaT, T, nullptr, nullptr}; pg8::gemm_phase(lds, g, S, E); }
    }
    SEAM(1);
    if (IN(2)) phase_mla_prep(a, vcu, G);
    SEAM(2);
    if (IN(3)) {
        { pg8::Gemm g{cq, (const bf16_t*)(ws + WS_WUQT), T, 1536, 384, 384, 384}; S.init(T, 1536, G, bx);
          EpiQb E{Qb, rq, tcos, tsin}; pg8::gemm_phase(lds, g, S, E); }
        { pg8::Gemm g{ckv, (const bf16_t*)(ws + WS_WUKT), T, 1024, 256, 256, 256}; S.init(T, 1024, G, bx);
          EpiBf16<true, false> E{Kb, 1024, rkv, nullptr}; pg8::gemm_phase(lds, g, S, E); }
        { pg8::Gemm g{(const bf16_t*)(ws + WS_WUVT), ckv, 1024, T, 256, 256, 256}; S.init(1024, T, G, bx);
          EpiBf16<false, true> E{VbT, T, nullptr, rkv}; pg8::gemm_phase(lds, g, S, E); }
    }
    SEAM(3);
    if (IN(4)) phase_attn(a, lds, vcu, G);
    SEAM(4);
    if (IN(5)) { pg8::Gemm g{Qa, (const bf16_t*)(ws + WS_WPAT), T, 1024, 1024, 1024, 1024}; S.init(T, 1024, G, bx);
        EpiMix<0> E{Ga, nullptr, (bf16_t*)a.out}; pg8::gemm_phase(lds, g, S, E); }
    if (IN(6)) { pg8::Gemm g{Qb, (const bf16_t*)(ws + WS_WPBT), T, 1024, 1024, 1536, 1024}; S.init(T, 1024, G, bx);
        EpiMix<1> E{Gb, (const bf16_t*)a.out, (bf16_t*)(ws + WS_MERGED)}; pg8::gemm_phase(lds, g, S, E); }
    SEAM(6);
    if (IN(7)) { pg8::Gemm g{(const bf16_t*)(ws + WS_MERGED), (const bf16_t*)(ws + WS_WOT), T, 1024, 1024, 1024, 1024}; S.init(T, 1024, G, bx);
        EpiMix<2> E{nullptr, nullptr, (bf16_t*)(ws + WS_T2)}; pg8::gemm_phase(lds, g, S, E); }
    SEAM(7);
    if (IN(8)) phase_post_mix(a, vcu, G);
    SEAM(8);
    if (IN(9)) { pg8::Gemm g{(const bf16_t*)(ws + WS_H2), (const bf16_t*)(ws + WS_WGUT), T, 5632, 1024, 1024, 1024}; S.init(T, 5632, G, bx);
        EpiSwiglu E{(bf16_t*)(ws + WS_U)}; pg8::gemm_phase(lds, g, S, E); }
    SEAM(9);
    if (IN(10)) { pg8::Gemm g{(const bf16_t*)(ws + WS_U), (const bf16_t*)(ws + WS_WDT), T, 1024, DFF, DFF, DFF}; S.init(T, 1024, G, bx);
        EpiMix<2> E{nullptr, nullptr, (bf16_t*)(ws + WS_F)}; pg8::gemm_phase(lds, g, S, E); }
    SEAM(10);
    if (IN(11)) phase_final(a, vcu, G);
#undef IN
#undef SEAM
}

constexpr int N_PHASES = 12;
#ifndef MK_MULTI
#define MK_MULTI 0
#endif

extern "C" void kernel_launch(void* const* d_in, const int* in_sizes, int n_in, void* d_out, int out_size, void* d_ws, size_t ws_size, hipStream_t stream) {
    static int grid = 0;
    if (grid == 0) {
        if (n_in != 22 || in_sizes[0] != T * DM || out_size != T * DM || ws_size < WS_END) { fprintf(stderr, "kernel_launch: unexpected shapes / workspace (%zu)\n", ws_size); grid = -1; return; }
        int dev = 0, cus = 0, per_cu = 0;
        (void)hipGetDevice(&dev);
        (void)hipDeviceGetAttribute(&cus, hipDeviceAttributeMultiprocessorCount, dev);
        (void)hipFuncSetAttribute((const void*)fwd_kernel, hipFuncAttributeMaxDynamicSharedMemorySize, LDS_BYTES);
        (void)hipOccupancyMaxActiveBlocksPerMultiprocessor(&per_cu, (const void*)fwd_kernel, NTHR, LDS_BYTES);
        if (per_cu < 1) per_cu = 1;
        grid = cus * per_cu;
        (void)hipGetLastError();
    }
    if (grid < 0) return;
    (void)hipMemsetAsync((unsigned char*)d_ws + WS_BAR, 0, WS_BAR_BYTES, stream);
    Args a;
    memset(&a, 0, sizeof(a));
    a.x = (const float*)d_in[0]; a.pos = (const int*)d_in[1]; a.ln_mix_pre = (const float*)d_in[2]; a.w_in = (const float*)d_in[3];
    a.lq1 = (const float*)d_in[4]; a.lk1 = (const float*)d_in[5]; a.lq2 = (const float*)d_in[6]; a.lk2 = (const float*)d_in[7];
    a.da_subln = (const float*)d_in[8]; a.q_a_norm = (const float*)d_in[9]; a.w_uq = (const float*)d_in[10]; a.kv_a_norm = (const float*)d_in[11]; a.w_ukv = (const float*)d_in[12];
    a.w_pa = (const float*)d_in[13]; a.w_pb = (const float*)d_in[14]; a.w_o = (const float*)d_in[15]; a.ln_mix_post = (const float*)d_in[16]; a.ln_ffn_pre = (const float*)d_in[17];
    a.w_g = (const float*)d_in[18]; a.w_u = (const float*)d_in[19]; a.w_d = (const float*)d_in[20]; a.ln_ffn_post = (const float*)d_in[21];
    a.out = (float*)d_out; a.ws = (unsigned char*)d_ws;
    for (int i = 0; i < 32; ++i) a.invf[i] = 1.0 / pow(10000.0, (double)i * (2.0 / 64.0));
#if MK_MULTI
    for (int ph = 0; ph < N_PHASES; ++ph) {
        a.ph_lo = ph; a.ph_hi = ph + 1;
        hipLaunchKernelGGL(fwd_kernel, dim3(grid), dim3(NTHR), LDS_BYTES, stream, a);
    }
#else
    a.ph_lo = 0; a.ph_hi = N_PHASES;
    void* args[] = {&a};
    hipError_t e = hipLaunchCooperativeKernel((const void*)fwd_kernel, dim3(grid), dim3(NTHR), args, LDS_BYTES, stream);
    if (e != hipSuccess) fprintf(stderr, "cooperative launch failed: %s (grid %d)\n", hipGetErrorString(e), grid);
#endif
}
```

```cpp
#include <hip/hip_runtime.h>
#include <hip/hip_cooperative_groups.h>
#include <cstdio>
#include <cstdint>
#include <cmath>
#include <cstring>
namespace cg = cooperative_groups;

#define LAS __attribute__((address_space(3)))
typedef unsigned short bf16_t;
typedef short bf16x8 __attribute__((ext_vector_type(8)));
typedef float f32x4 __attribute__((ext_vector_type(4)));
typedef float f32x16 __attribute__((ext_vector_type(16)));
typedef unsigned u32x4 __attribute__((ext_vector_type(4)));
typedef unsigned u32x2 __attribute__((ext_vector_type(2)));
typedef float f32x2_t __attribute__((ext_vector_type(2)));
typedef __bf16 bf16x2_t __attribute__((ext_vector_type(2)));

constexpr int BATCH = 4, SEQ = 8192, DM = 1024, T = BATCH * SEQ;
constexpr int DFF = 2816;
constexpr int IN_COLS = 5824;
constexpr int N1 = 4864;
constexpr float RMS_EPS = 1e-6f;
constexpr float LAMBDA_INIT = 0.2f;
constexpr int NTHR = 512;
constexpr float C2_DA = 0.125f * 1.4426950408889634f, C2_MLA = 0.07216878364870322f * 1.4426950408889634f;
constexpr int RP = 4;

constexpr size_t MiB = 1u << 20;
constexpr size_t WS_CTL = 0;
constexpr size_t WS_RSTDQ = 256 * 1024, WS_RSTDKV = 512 * 1024;
constexpr size_t WS_BAR = 64 * 1024, WS_BAR_BYTES = 16 * 1024;
constexpr size_t WS_W1T = 1 * MiB;
constexpr size_t WS_WVT = WS_W1T + (size_t)N1 * 1024 * 2;
constexpr size_t WS_WUQT = WS_WVT + (size_t)1024 * 1024 * 2;
constexpr size_t WS_WUKT = WS_WUQT + (size_t)1536 * 384 * 2;
constexpr size_t WS_WUVT = WS_WUKT + (size_t)1024 * 256 * 2;
constexpr size_t WS_WPAT = WS_WUVT + (size_t)1024 * 256 * 2;
constexpr size_t WS_WPBT = WS_WPAT + (size_t)1024 * 1024 * 2;
constexpr size_t WS_WOT = WS_WPBT + (size_t)1024 * 1024 * 2;
constexpr size_t WS_WGUT = WS_WOT + (size_t)1024 * 1024 * 2;
constexpr size_t WS_WDT = WS_WGUT + (size_t)5632 * 1024 * 2;
constexpr size_t WS_WEND = WS_WDT + (size_t)1024 * 2816 * 2;
static_assert(WS_WEND <= 38 * MiB, "weights");
constexpr size_t WS_TCOS = 38 * MiB, WS_TSIN = 42 * MiB;
constexpr size_t WS_QA = 46 * MiB, WS_KA = 110 * MiB, WS_GA = 174 * MiB, WS_GB = 238 * MiB, WS_VAT = 302 * MiB;
constexpr size_t WS_CQ = 366 * MiB, WS_CKV = 390 * MiB, WS_KR = 406 * MiB, WS_H = 410 * MiB, WS_QB = 410 * MiB;
constexpr size_t WS_END = 506 * MiB;
constexpr size_t WS_MERGED = WS_KA, WS_H2 = WS_QA, WS_U = WS_GA, WS_F = WS_QA, WS_T2 = WS_QB;
constexpr size_t OUT_KB = 0, OUT_VBT = 64 * MiB;

constexpr int LDS_BYTES = 135168;

__device__ __forceinline__ unsigned cvtpk(float lo, float hi) { f32x2_t v = {lo, hi}; bf16x2_t b = __builtin_convertvector(v, bf16x2_t); return __builtin_bit_cast(unsigned, b); }
__device__ __forceinline__ float bf2f(unsigned short u) { return __uint_as_float(((unsigned)u) << 16); }
__device__ __forceinline__ float bflo(unsigned u) { return __uint_as_float(u << 16); }
__device__ __forceinline__ float bfhi(unsigned u) { return __uint_as_float(u & 0xffff0000u); }
__device__ __forceinline__ float wave_sum(float v) {
#pragma unroll
    for (int o = 1; o < 64; o <<= 1) v += __shfl_xor(v, o);
    return v;
}
__device__ __forceinline__ float xhalf(float v) {
    return __shfl_xor(v, 32);
}
__device__ __forceinline__ float xhalf_max(float v) {
    auto rr = __builtin_amdgcn_permlane32_swap(__float_as_uint(v), __float_as_uint(v), false, false);
    return fmaxf(__uint_as_float(rr[0]), __uint_as_float(rr[1]));
}
__device__ __forceinline__ float xhalf_sum(float v) {
    auto rr = __builtin_amdgcn_permlane32_swap(__float_as_uint(v), __float_as_uint(v), false, false);
    return __uint_as_float(rr[0]) + __uint_as_float(rr[1]);
}
__device__ __forceinline__ void store8(bf16_t* p, f32x4 a, f32x4 b) {
    u32x4 w; w.x = cvtpk(a[0], a[1]); w.y = cvtpk(a[2], a[3]); w.z = cvtpk(b[0], b[1]); w.w = cvtpk(b[2], b[3]);
    *(u32x4*)p = w;
}

namespace pg8 {
constexpr int BM = 256, BK = 64, HALF = 128, HTB = HALF * BK * 2, STAGE_BYTES = 8 * HTB, NXCD = 8, WGM = 4;
__host__ __device__ __forceinline__ int lds_byte(int r, int c) { const int st = (r >> 4) * 2 + (c >> 5), rr = r & 15, cc = c & 31, ob = rr * 64 + cc * 2; return st * 1024 + (ob ^ (((ob >> 9) & 1) << 5)); }
__host__ __device__ __forceinline__ void stage_rc(int b, int& R, int& C) { const int st = b / 1024, sb = b % 1024, swz = sb ^ (((sb >> 9) & 1) << 5); R = (st >> 1) * 16 + swz / 64; C = (st & 1) * 32 + (swz % 64) / 2; }
__host__ __device__ __forceinline__ int perm32(int rho) { const int n = rho >> 4, i = rho & 15; return 8 * (i >> 2) + 4 * n + (i & 3); }

struct Unit { int pm, pn; };
struct Gemm { const bf16_t* A; const bf16_t* Bt; int M, N, K, lda, ldb; };

struct StaticOrder {
    int nM, nN, nwg, G, c, bal;
    __device__ void init(int M, int N, int G_, int c_, int bal_ = 0) { nM = M / BM; nN = N / BM; nwg = nM * nN; G = G_; c = c_; bal = bal_; }
    __device__ bool next(int i, Unit& u) const {
        long L;
        if (bal > 0) { if (c < bal) { if (i > 0) return false; L = c; } else { if (i > 2) return false; L = bal + 3 * (c - bal) + i; } }
        else L = (long)i * G + c;
        if (L >= nwg) return false;
        int wgid = (int)L; { const int q = nwg / NXCD, r = nwg % NXCD, xcd = wgid % NXCD, off = wgid / NXCD; wgid = (xcd < r ? xcd * (q + 1) : r * (q + 1) + (xcd - r) * q) + off; }
        const int nig = WGM * nN, gid = wgid / nig, fm = gid * WGM, gsz = (nM - fm) < WGM ? (nM - fm) : WGM;
        u.pm = fm + ((wgid % nig) % gsz); u.pn = (wgid % nig) / gsz; return true;
    }
};

template <class Epi>
__device__ __forceinline__ void gemm_phase(LAS unsigned char* lds, const Gemm g, const StaticOrder& S, const Epi& E) {
    const int tid = threadIdx.x, wid = __builtin_amdgcn_readfirstlane(tid >> 6), lane = tid & 63, wr = wid >> 2, wc = wid & 3, fr = lane & 15, fq = lane >> 4;
    int K = g.K; asm volatile("" : "+s"(K)); const int nt = K / BK;
    unsigned voffA[2], voffB[2];
#pragma unroll
    for (int i = 0; i < 2; ++i) { int R, C; stage_rc(tid * 16 + i * 8192, R, C); const int Rb = (R & ~31) + perm32(R & 31);
        voffA[i] = (unsigned)(R * g.lda + C) * 2u; voffB[i] = (unsigned)(Rb * g.ldb + C) * 2u; }
    const size_t kstep = (size_t)(BK * 2);
    const size_t hstepA = (size_t)HALF * g.lda * 2, hstepB = (size_t)HALF * g.ldb * 2;
    const size_t tstepA = 2 * hstepA, tstepB = 2 * hstepB;
    const unsigned ldsw = (unsigned)wid * 1024u;
    const int aoff = lds_byte(wr * 64 + fr, fq * 8), boff = lds_byte(wc * 32 + fr, fq * 8);
#define PG8_SA(b, h) (((b) * 2 + (h)) * HTB)
#define PG8_SB(b, h) ((4 + (b) * 2 + (h)) * HTB)
#define PG8_STAGE(bufoff, gbase, voff) do { _Pragma("unroll") for (int _i = 0; _i < 2; ++_i) \
        __builtin_amdgcn_global_load_lds((const unsigned*)((const char*)(gbase) + (voff)[_i]), (LAS unsigned*)(lds + (bufoff) + ldsw + _i * 8192), 16, 0, 0); } while (0)
#define PG8_LDA(dst, b, h) do { _Pragma("unroll") for (int m = 0; m < 4; ++m) _Pragma("unroll") for (int k = 0; k < 2; ++k) dst[m][k] = *(const LAS bf16x8*)(lds + PG8_SA(b, h) + aoff + m * 2048 + k * 1024); } while (0)
#define PG8_LDB(dst, b, h) do { _Pragma("unroll") for (int n = 0; n < 2; ++n) _Pragma("unroll") for (int k = 0; k < 2; ++k) dst[n][k] = *(const LAS bf16x8*)(lds + PG8_SB(b, h) + boff + n * 2048 + k * 1024); } while (0)
#define PG8_MMA(ai, bj, At, Bt) do { __builtin_amdgcn_s_setprio(1); _Pragma("unroll") for (int m = 0; m < 4; ++m) _Pragma("unroll") for (int n = 0; n < 2; ++n) _Pragma("unroll") for (int k = 0; k < 2; ++k) \
        acc[ai][bj][m][n] = __builtin_amdgcn_mfma_f32_16x16x32_bf16(Bt[n][k], At[m][k], acc[ai][bj][m][n], 0, 0, 0); __builtin_amdgcn_s_setprio(0); } while (0)
#define PG8_WAIT_V(n) asm volatile("s_waitcnt vmcnt(" #n ")" ::: "memory")
#define PG8_WAIT_L(n) asm volatile("s_waitcnt lgkmcnt(" #n ")" ::: "memory")
#define PG8_BAR __builtin_amdgcn_s_barrier()
#define PG8_SCHED __builtin_amdgcn_sched_barrier(0)
    Unit cur, nxt; int ui = 0;
    if (!S.next(0, cur)) return;
    f32x4 acc[2][2][4][2];
#pragma unroll
    for (int a = 0; a < 2; ++a)
#pragma unroll
        for (int b = 0; b < 2; ++b)
#pragma unroll
            for (int m = 0; m < 4; ++m)
#pragma unroll
                for (int n = 0; n < 2; ++n) acc[a][b][m][n] = (f32x4){0.f, 0.f, 0.f, 0.f};
    bf16x8 At[4][2], B0[2][2], B1[2][2];
    const char* cA = (const char*)g.A + (size_t)cur.pm * tstepA; const char* cB = (const char*)g.Bt + (size_t)cur.pn * tstepB;
    PG8_STAGE(PG8_SB(0, 0), cB, voffB); PG8_STAGE(PG8_SB(0, 1), cB + hstepB, voffB); PG8_STAGE(PG8_SA(0, 0), cA, voffA); PG8_STAGE(PG8_SA(0, 1), cA + hstepA, voffA);
    if (wr == 1) PG8_BAR;
    PG8_WAIT_V(2); PG8_BAR;
    PG8_STAGE(PG8_SB(1, 0), cB + kstep, voffB); PG8_STAGE(PG8_SA(1, 0), cA + kstep, voffA); PG8_STAGE(PG8_SB(1, 1), cB + hstepB + kstep, voffB);
    PG8_WAIT_V(6); PG8_BAR;
    for (;;) {
        const bool has_next = S.next(ui + 1, nxt);
        const char* nA = has_next ? (const char*)g.A + (size_t)nxt.pm * tstepA : cA; const char* nB = has_next ? (const char*)g.Bt + (size_t)nxt.pn * tstepB : cB;
#pragma unroll 1
        for (int t = 0; t < nt; t += 2) {
            const bool last = (t == nt - 2);
            const char* a1 = cA + (size_t)(t + 1) * kstep;
            const char* a2 = last ? nA : cA + (size_t)(t + 2) * kstep; const char* b2 = last ? nB : cB + (size_t)(t + 2) * kstep;
            const char* a3 = a2 + kstep; const char* b3 = b2 + kstep;
            PG8_LDB(B0, 0, 0); PG8_LDB(B1, 0, 1); PG8_SCHED; PG8_LDA(At, 0, 0); PG8_STAGE(PG8_SA(1, 1), a1 + hstepA, voffA);
            PG8_WAIT_V(8); PG8_WAIT_L(0); PG8_BAR; PG8_MMA(0, 0, At, B0); PG8_MMA(0, 1, At, B1); PG8_BAR; PG8_SCHED;
            PG8_LDA(At, 0, 1); PG8_STAGE(PG8_SB(0, 0), b2, voffB); PG8_STAGE(PG8_SB(0, 1), b2 + hstepB, voffB); PG8_STAGE(PG8_SA(0, 0), a2, voffA);
            PG8_WAIT_V(8); PG8_WAIT_L(0); PG8_BAR; PG8_MMA(1, 0, At, B0); PG8_MMA(1, 1, At, B1); PG8_BAR; PG8_SCHED;
            PG8_LDB(B0, 1, 0); PG8_LDB(B1, 1, 1); PG8_SCHED; PG8_LDA(At, 1, 0); PG8_STAGE(PG8_SA(0, 1), a2 + hstepA, voffA);
            PG8_WAIT_V(8); PG8_WAIT_L(0); PG8_BAR; PG8_MMA(0, 0, At, B0); PG8_MMA(0, 1, At, B1); PG8_BAR; PG8_SCHED;
            PG8_LDA(At, 1, 1); PG8_STAGE(PG8_SB(1, 0), b3, voffB); PG8_STAGE(PG8_SB(1, 1), b3 + hstepB, voffB); PG8_STAGE(PG8_SA(1, 0), a3, voffA);
            PG8_WAIT_V(8); PG8_WAIT_L(0); PG8_BAR; PG8_MMA(1, 0, At, B0); PG8_MMA(1, 1, At, B1); PG8_BAR; PG8_SCHED;
        }
        if (wr == 0) PG8_BAR;
        E(acc, cur, wr, wc, fr, fq);
        if (!has_next) break;
#pragma unroll
        for (int a = 0; a < 2; ++a)
#pragma unroll
            for (int b = 0; b < 2; ++b)
#pragma unroll
                for (int m = 0; m < 4; ++m)
#pragma unroll
                    for (int n = 0; n < 2; ++n) acc[a][b][m][n] = (f32x4){0.f, 0.f, 0.f, 0.f};
        cur = nxt; cA = nA; cB = nB; ++ui;
        if (wr == 1) PG8_BAR;
    }
    PG8_WAIT_V(0);
    PG8_BAR;
#undef PG8_SA
#undef PG8_SB
#undef PG8_STAGE
#undef PG8_LDA
#undef PG8_LDB
#undef PG8_MMA
#undef PG8_WAIT_V
#undef PG8_WAIT_L
#undef PG8_BAR
#undef PG8_SCHED
}
}

typedef f32x4 Acc[2][2][4][2];
using pg8::Unit;

struct EpiG1 {
    bf16_t *Qa, *Ka, *Ga, *Gb, *cq, *ckv, *kr; const float *tcos, *tsin;
    __device__ __forceinline__ void operator()(const Acc& acc, const Unit& u, int wr, int wc, int fr, int fq) const {
        const int pn = u.pn, row0 = u.pm * 256 + wr * 64 + fr;
        if (pn < 8) {
            bf16_t* dst = pn < 4 ? Qa : Ka; const int colbase = (pn & 3) * 256 + wc * 64 + 8 * fq;
            const float qs = pn < 4 ? C2_DA : 1.f;
            f32x4 tc[2][2], ts[2][2];
            { const size_t r = (size_t)row0; tc[0][0] = *(const f32x4*)(tcos + r * 32 + 8 * fq); tc[0][1] = *(const f32x4*)(tcos + r * 32 + 8 * fq + 4);
              ts[0][0] = *(const f32x4*)(tsin + r * 32 + 8 * fq); ts[0][1] = *(const f32x4*)(tsin + r * 32 + 8 * fq + 4); }
#pragma unroll
            for (int it = 0; it < 8; ++it) {
                const int ai = it >> 2, m = it & 3;
                const size_t r = (size_t)(row0 + ai * 128 + m * 16);
                if (it + 1 < 8) { const size_t rn = (size_t)(row0 + ((it + 1) >> 2) * 128 + ((it + 1) & 3) * 16);
                    tc[(it + 1) & 1][0] = *(const f32x4*)(tcos + rn * 32 + 8 * fq); tc[(it + 1) & 1][1] = *(const f32x4*)(tcos + rn * 32 + 8 * fq + 4);
                    ts[(it + 1) & 1][0] = *(const f32x4*)(tsin + rn * 32 + 8 * fq); ts[(it + 1) & 1][1] = *(const f32x4*)(tsin + rn * 32 + 8 * fq + 4); }
                const f32x4 c0 = tc[it & 1][0], c1 = tc[it & 1][1], s0 = ts[it & 1][0], s1 = ts[it & 1][1];
                const f32x4 a0 = acc[ai][0][m][0], a1 = acc[ai][0][m][1], b0 = acc[ai][1][m][0], b1 = acc[ai][1][m][1];
                store8(dst + r * 1024 + colbase, (a0 * c0 - b0 * s0) * qs, (a1 * c1 - b1 * s1) * qs);
                store8(dst + r * 1024 + colbase + 32, (b0 * c0 + a0 * s0) * qs, (b1 * c1 + a1 * s1) * qs);
                asm volatile("" ::: "memory");
            }
        } else if (pn < 16) {
            bf16_t* dst = pn < 12 ? Ga : Gb; const int colbase = ((pn - 8) & 3) * 256 + wc * 32 + 8 * fq;
#pragma unroll
            for (int ai = 0; ai < 2; ++ai)
#pragma unroll
                for (int m = 0; m < 4; ++m) {
                    const size_t r = (size_t)(row0 + ai * 128 + m * 16);
#pragma unroll
                    for (int bj = 0; bj < 2; ++bj) {
                        f32x4 v0 = acc[ai][bj][m][0], v1 = acc[ai][bj][m][1];
#pragma unroll
                        for (int e = 0; e < 4; ++e) { v0[e] = __builtin_amdgcn_rcpf(1.f + __builtin_amdgcn_exp2f(v0[e] * -1.4426950408889634f)); v1[e] = __builtin_amdgcn_rcpf(1.f + __builtin_amdgcn_exp2f(v1[e] * -1.4426950408889634f)); }
                        store8(dst + r * 1024 + colbase + bj * 128, v0, v1);
                    }
                }
        } else {
#pragma unroll
            for (int bj = 0; bj < 2; ++bj) {
                const int hidx = 2 * (pn - 16) + bj;
                bf16_t* dst; int ld, col;
                if (hidx < 3) { dst = cq; ld = 384; col = hidx * 128 + wc * 32 + 8 * fq; }
                else if (hidx < 5) { dst = ckv; ld = 256; col = (hidx - 3) * 128 + wc * 32 + 8 * fq; }
                else { dst = kr; ld = 64; col = wc * 32 + 8 * fq; if (wc >= 2) continue; }
#pragma unroll
                for (int ai = 0; ai < 2; ++ai)
#pragma unroll
                    for (int m = 0; m < 4; ++m) {
                        const size_t r = (size_t)(row0 + ai * 128 + m * 16);
                        store8(dst + r * ld + col, acc[ai][bj][m][0], acc[ai][bj][m][1]);
                    }
            }
        }
    }
};
template <bool RS, bool CS> struct EpiBf16 {
    bf16_t* O; int ld; const float* rs; const float* cs;
    __device__ __forceinline__ void operator()(const Acc& acc, const Unit& u, int wr, int wc, int fr, int fq) const {
        const int row0 = u.pm * 256 + wr * 64 + fr, col0 = u.pn * 256 + wc * 32 + 8 * fq;
        float rsv[8];
#pragma unroll
        for (int it = 0; it < 8; ++it) rsv[it] = RS ? rs[row0 + (it >> 2) * 128 + (it & 3) * 16] : 1.f;
#pragma unroll
        for (int bj = 0; bj < 2; ++bj) {
            f32x4 cv0 = (f32x4){1.f, 1.f, 1.f, 1.f}, cv1 = cv0;
            if (CS) { cv0 = *(const f32x4*)(cs + col0 + bj * 128); cv1 = *(const f32x4*)(cs + col0 + bj * 128 + 4); }
#pragma unroll
            for (int ai = 0; ai < 2; ++ai)
#pragma unroll
                for (int m = 0; m < 4; ++m) {
                    const size_t r = (size_t)(row0 + ai * 128 + m * 16);
                    f32x4 v0 = acc[ai][bj][m][0], v1 = acc[ai][bj][m][1];
                    if (CS) { v0 = v0 * cv0; v1 = v1 * cv1; }
                    if (RS) { const float sc = rsv[ai * 4 + m]; v0 = v0 * sc; v1 = v1 * sc; }
                    store8(O + r * ld + col0 + bj * 128, v0, v1);
                    asm volatile("" ::: "memory");
                }
        }
    }
};
struct EpiQb {
    bf16_t* Qb; const float* rs; const float *tcos, *tsin;
    __device__ __forceinline__ void operator()(const Acc& acc, const Unit& u, int wr, int wc, int fr, int fq) const {
        const int pn = u.pn, row0 = u.pm * 256 + wr * 64 + fr;
        float rsv[8];
#pragma unroll
        for (int it = 0; it < 8; ++it) rsv[it] = rs[row0 + (it >> 2) * 128 + (it & 3) * 16] * C2_MLA;
        if (pn < 4) {
#pragma unroll
            for (int it = 0; it < 8; ++it) {
                const int ai = it >> 2, m = it & 3; const size_t r = (size_t)(row0 + ai * 128 + m * 16); const float sc = rsv[it];
#pragma unroll
                for (int bj = 0; bj < 2; ++bj)
                    store8(Qb + r * 1536 + pn * 256 + bj * 128 + wc * 32 + 8 * fq, acc[ai][bj][m][0] * sc, acc[ai][bj][m][1] * sc);
                asm volatile("" ::: "memory");
            }
        } else {
            const int colbase = 1024 + (4 * (pn - 4) + wc) * 64 + 8 * fq;
            f32x4 tc[2][2], ts[2][2];
            { const size_t r = (size_t)row0; tc[0][0] = *(const f32x4*)(tcos + r * 32 + 8 * fq); tc[0][1] = *(const f32x4*)(tcos + r * 32 + 8 * fq + 4);
              ts[0][0] = *(const f32x4*)(tsin + r * 32 + 8 * fq); ts[0][1] = *(const f32x4*)(tsin + r * 32 + 8 * fq + 4); }
#pragma unroll
            for (int it = 0; it < 8; ++it) {
                const int ai = it >> 2, m = it & 3; const size_t r = (size_t)(row0 + ai * 128 + m * 16); const float sc = rsv[it];
                if (it + 1 < 8) { const size_t rn = (size_t)(row0 + ((it + 1) >> 2) * 128 + ((it + 1) & 3) * 16);
                    tc[(it + 1) & 1][0] = *(const f32x4*)(tcos + rn * 32 + 8 * fq); tc[(it + 1) & 1][1] = *(const f32x4*)(tcos + rn * 32 + 8 * fq + 4);
                    ts[(it + 1) & 1][0] = *(const f32x4*)(tsin + rn * 32 + 8 * fq); ts[(it + 1) & 1][1] = *(const f32x4*)(tsin + rn * 32 + 8 * fq + 4); }
                const f32x4 c0 = tc[it & 1][0], c1 = tc[it & 1][1], s0 = ts[it & 1][0], s1 = ts[it & 1][1];
                const f32x4 a0 = acc[ai][0][m][0] * sc, a1 = acc[ai][0][m][1] * sc, b0 = acc[ai][1][m][0] * sc, b1 = acc[ai][1][m][1] * sc;
                store8(Qb + r * 1536 + colbase, a0 * c0 - b0 * s0, a1 * c1 - b1 * s1);
                store8(Qb + r * 1536 + colbase + 32, b0 * c0 + a0 * s0, b1 * c1 + a1 * s1);
                asm volatile("" ::: "memory");
            }
        }
    }
};
template <int MODE> struct EpiMix {
    const bf16_t* G; const bf16_t* T1; bf16_t* O;
    __device__ __forceinline__ void operator()(const Acc& acc, const Unit& u, int wr, int wc, int fr, int fq) const {
        const int row0 = u.pm * 256 + wr * 64 + fr, col0 = u.pn * 256 + wc * 32 + 8 * fq;
#pragma unroll
        for (int ai = 0; ai < 2; ++ai) {
            u32x4 gw[4][2], tw[4][2];
            if (MODE != 2) {
#pragma unroll
                for (int m = 0; m < 4; ++m)
#pragma unroll
                    for (int bj = 0; bj < 2; ++bj) { const size_t off = (size_t)(row0 + ai * 128 + m * 16) * 1024 + col0 + bj * 128;
                        gw[m][bj] = *(const u32x4*)(G + off); if (MODE == 1) tw[m][bj] = *(const u32x4*)(T1 + off); }
            }
#pragma unroll
            for (int m = 0; m < 4; ++m) {
                const size_t r = (size_t)(row0 + ai * 128 + m * 16);
#pragma unroll
                for (int bj = 0; bj < 2; ++bj) {
                    const size_t off = r * 1024 + col0 + bj * 128;
                    f32x4 v0 = acc[ai][bj][m][0], v1 = acc[ai][bj][m][1];
                    if (MODE != 2) {
                        const u32x4 g = gw[m][bj];
                        v0 = v0 * (f32x4){bflo(g.x), bfhi(g.x), bflo(g.y), bfhi(g.y)};
                        v1 = v1 * (f32x4){bflo(g.z), bfhi(g.z), bflo(g.w), bfhi(g.w)};
                    }
                    if (MODE == 1) {
                        const u32x4 t = tw[m][bj];
                        v0 = v0 + (f32x4){bflo(t.x), bfhi(t.x), bflo(t.y), bfhi(t.y)};
                        v1 = v1 + (f32x4){bflo(t.z), bfhi(t.z), bflo(t.w), bfhi(t.w)};
                    }
                    store8(O + off, v0, v1);
                }
            }
            asm volatile("" ::: "memory");
        }
    }
};
struct EpiSwiglu {
    bf16_t* U;
    __device__ __forceinline__ void operator()(const Acc& acc, const Unit& u, int wr, int wc, int fr, int fq) const {
        const int row0 = u.pm * 256 + wr * 64 + fr, col0 = u.pn * 128 + wc * 32 + 8 * fq;
#pragma unroll
        for (int ai = 0; ai < 2; ++ai)
#pragma unroll
            for (int m = 0; m < 4; ++m) {
                const size_t r = (size_t)(row0 + ai * 128 + m * 16);
                f32x4 g0 = acc[ai][0][m][0], g1 = acc[ai][0][m][1];
                const f32x4 u0 = acc[ai][1][m][0], u1 = acc[ai][1][m][1];
#pragma unroll
                for (int e = 0; e < 4; ++e) { g0[e] = g0[e] * __builtin_amdgcn_rcpf(1.f + __builtin_amdgcn_exp2f(g0[e] * -1.4426950408889634f)); g1[e] = g1[e] * __builtin_amdgcn_rcpf(1.f + __builtin_amdgcn_exp2f(g1[e] * -1.4426950408889634f)); }
                store8(U + r * DFF + col0, g0 * u0, g1 * u1);
            }
    }
};

struct Args {
    const float* x; const int* pos; const float* ln_mix_pre; const float* w_in;
    const float *lq1, *lk1, *lq2, *lk2; const float* da_subln; const float* q_a_norm; const float* w_uq; const float* kv_a_norm; const float* w_ukv;
    const float *w_pa, *w_pb, *w_o; const float *ln_mix_post, *ln_ffn_pre; const float *w_g, *w_u, *w_d; const float* ln_ffn_post;
    float* out; unsigned char* ws;
    double invf[32];
    int ph_lo, ph_hi;
};

__device__ __forceinline__ void transpose_item(const float* src, int ldsrc, const float* gain, bf16_t* dst, int K, int k0, int n0, LAS float* scr, int lane) {
    if (src) {
#pragma unroll
        for (int i = 0; i < 32; ++i) { const int kk = 2 * i + (lane >> 5); float v = src[(size_t)(k0 + kk) * ldsrc + (lane & 31)]; if (gain) v *= gain[k0 + kk]; scr[kk * 33 + (lane & 31)] = v; }
    } else {
#pragma unroll 8
        for (int i = 0; i < 32; ++i) { const int kk = 2 * i + (lane >> 5); scr[kk * 33 + (lane & 31)] = 0.f; }
    }
    asm volatile("s_waitcnt lgkmcnt(0)" ::: "memory");
    const int c = lane & 7;
#pragma unroll
    for (int j = 0; j < 4; ++j) { const int n = (lane >> 3) + 8 * j; const LAS float* s = scr + (8 * c) * 33 + n;
        u32x4 o; o.x = cvtpk(s[0 * 33], s[1 * 33]); o.y = cvtpk(s[2 * 33], s[3 * 33]); o.z = cvtpk(s[4 * 33], s[5 * 33]); o.w = cvtpk(s[6 * 33], s[7 * 33]);
        *(u32x4*)(dst + (size_t)(n0 + n) * K + k0 + 8 * c) = o; }
    asm volatile("s_waitcnt lgkmcnt(0)" ::: "memory");
}

__device__ __forceinline__ void phase0(const Args& a, LAS unsigned char* lds, int vcu, int G) {
    const int tid = threadIdx.x, lane = tid & 63, wave = __builtin_amdgcn_readfirstlane(tid >> 6);
    LAS float* scr = (LAS float*)(lds + wave * 16384);
    const int gw = vcu * 8 + wave, NGW = G * 8;
    unsigned char* ws = a.ws;
    constexpr int I_W1 = 16 * (N1 / 32), I_WV = 16 * 32, I_UQ = 6 * 48, I_UK = 4 * 32, I_UV = 4 * 32, I_SQ = 16 * 32, I_GU = 16 * 176, I_D = 44 * 32;
    constexpr int NITEMS = I_W1 + I_WV + I_UQ + I_UK + I_UV + 3 * I_SQ + I_GU + I_D;
    for (int it = gw; it < NITEMS; it += NGW) {
        int r = it;
        if (r < I_W1) {
            const int nb = r % (N1 / 32), kb = r / (N1 / 32), n0 = nb * 32; int sc;
            if (n0 < 2048) { const int base = n0 < 1024 ? 0 : 1024, q = n0 & 1023, t = q >> 8, j = q & 255, bj = j >> 7, p = j & 127, sh = p >> 5; sc = base + 256 * t + 64 * sh + 32 * bj; }
            else if (n0 < 3072) sc = 3776 + (n0 - 2048);
            else if (n0 < 4096) sc = 4800 + (n0 - 3072);
            else if (n0 < 4480) sc = 3072 + (n0 - 4096);
            else if (n0 < 4736) sc = 3456 + (n0 - 4480);
            else if (n0 < 4800) sc = 3712 + (n0 - 4736);
            else sc = -1;
            transpose_item(sc >= 0 ? a.w_in + sc : nullptr, IN_COLS, nullptr, (bf16_t*)(ws + WS_W1T), 1024, kb * 64, n0, scr, lane); continue; }
        r -= I_W1;
        if (r < I_WV) { const int nb = r % 32, kb = r / 32; transpose_item(a.w_in + 2048 + nb * 32, IN_COLS, nullptr, (bf16_t*)(ws + WS_WVT), 1024, kb * 64, nb * 32, scr, lane); continue; }
        r -= I_WV;
        if (r < I_UQ) { const int nb = r % 48, kb = r / 48, n0 = nb * 32; int sc;
            if (n0 < 1024) sc = (n0 >> 7) * 192 + (n0 & 127);
            else { const int q = n0 - 1024, tt = q >> 8, j = q & 255, bj = j >> 7, p = j & 127, hh = p >> 5; sc = (4 * tt + hh) * 192 + 128 + 32 * bj; }
            transpose_item(a.w_uq + sc, 1536, a.q_a_norm, (bf16_t*)(ws + WS_WUQT), 384, kb * 64, n0, scr, lane); continue; }
        r -= I_UQ;
        if (r < I_UK) { const int nb = r % 32, kb = r / 32, n0 = nb * 32; transpose_item(a.w_ukv + (n0 >> 7) * 256 + (n0 & 127), 2048, a.kv_a_norm, (bf16_t*)(ws + WS_WUKT), 256, kb * 64, n0, scr, lane); continue; }
        r -= I_UK;
        if (r < I_UV) { const int nb = r % 32, kb = r / 32, n0 = nb * 32; transpose_item(a.w_ukv + (n0 >> 7) * 256 + 128 + (n0 & 127), 2048, a.kv_a_norm, (bf16_t*)(ws + WS_WUVT), 256, kb * 64, n0, scr, lane); continue; }
        r -= I_UV;
        if (r < 3 * I_SQ) { const int w = r / I_SQ, q = r % I_SQ, nb = q % 32, kb = q / 32;
            const float* src = w == 0 ? a.w_pa : (w == 1 ? a.w_pb : a.w_o); bf16_t* dst = (bf16_t*)(ws + (w == 0 ? WS_WPAT : (w == 1 ? WS_WPBT : WS_WOT)));
            transpose_item(src + nb * 32, 1024, nullptr, dst, 1024, kb * 64, nb * 32, scr, lane); continue; }
        r -= 3 * I_SQ;
        if (r < I_GU) { const int nb = r % 176, kb = r / 176, n0 = nb * 32, t = n0 >> 8, j = n0 & 255, bj = j >> 7, p = j & 127;
            transpose_item((bj ? a.w_u : a.w_g) + 128 * t + p, DFF, nullptr, (bf16_t*)(ws + WS_WGUT), 1024, kb * 64, n0, scr, lane); continue; }
        r -= I_GU;
        { const int nb = r % 32, kb = r / 32; transpose_item(a.w_d + nb * 32, 1024, nullptr, (bf16_t*)(ws + WS_WDT), DFF, kb * 64, nb * 32, scr, lane); }
    }
    {
        float* tcos = (float*)(ws + WS_TCOS); float* tsin = (float*)(ws + WS_TSIN);
        for (int e = vcu * NTHR + tid; e < T * 32; e += G * NTHR) {
            const int t = e >> 5, i = e & 31;
            const double ang = (double)a.pos[t] * a.invf[i];
            const double q = rint(ang * 0.63661977236758134308);
            double rr = fma(-q, 1.57079632679489655800e+00, ang); rr = fma(-q, 6.12323399573676603587e-17, rr);
            const double r2 = rr * rr;
            double sp = 1.0 / 6227020800.0; sp = fma(sp, r2, -1.0 / 39916800.0); sp = fma(sp, r2, 1.0 / 362880.0); sp = fma(sp, r2, -1.0 / 5040.0); sp = fma(sp, r2, 1.0 / 120.0); sp = fma(sp, r2, -1.0 / 6.0);
            const double sn = fma(rr * r2, sp, rr);
            double cp = -1.0 / 87178291200.0; cp = fma(cp, r2, 1.0 / 479001600.0); cp = fma(cp, r2, -1.0 / 3628800.0); cp = fma(cp, r2, 1.0 / 40320.0); cp = fma(cp, r2, -1.0 / 720.0); cp = fma(cp, r2, 1.0 / 24.0); cp = fma(cp, r2, -0.5);
            const double cs = fma(r2, cp, 1.0);
            const int qi = ((int)q) & 3;
            const double s_out = (qi == 0) ? sn : (qi == 1) ? cs : (qi == 2) ? -sn : -cs;
            const double c_out = (qi == 0) ? cs : (qi == 1) ? -sn : (qi == 2) ? -cs : sn;
            tcos[e] = (float)c_out; tsin[e] = (float)s_out;
        }
    }
    if (vcu == 0 && tid < 64) {
        const float d1 = wave_sum(a.lq1[lane] * a.lk1[lane]), d2 = wave_sum(a.lq2[lane] * a.lk2[lane]);
        if (lane == 0) ((float*)(ws + WS_CTL))[0] = expf(d1) - expf(d2) + LAMBDA_INIT;
    }
    {
        bf16_t* H = (bf16_t*)(ws + WS_H);
        for (int m0 = gw; m0 < T; m0 += RP * NGW) {
            f32x4 v[RP][4]; float sq[RP];
#pragma unroll
            for (int r = 0; r < RP; ++r) { const int m = m0 + r * NGW < T ? m0 + r * NGW : m0; const f32x4* xr = (const f32x4*)(a.x + (size_t)m * DM) + lane;
#pragma unroll
                for (int j = 0; j < 4; ++j) v[r][j] = __builtin_nontemporal_load(xr + 64 * j); }
#pragma unroll
            for (int r = 0; r < RP; ++r) { float s = 0.f;
#pragma unroll
                for (int j = 0; j < 4; ++j) s += (v[r][j].x * v[r][j].x + v[r][j].y * v[r][j].y) + (v[r][j].z * v[r][j].z + v[r][j].w * v[r][j].w);
                sq[r] = s; }
#pragma unroll
            for (int r = 0; r < RP; ++r) { const int m = m0 + r * NGW; if (m >= T) break;
                const float rstd = 1.f / sqrtf(wave_sum(sq[r]) * (1.f / DM) + RMS_EPS);
                u32x2* o8 = (u32x2*)(H + (size_t)m * DM) + lane;
#pragma unroll
                for (int j = 0; j < 4; ++j) { const f32x4 g = ((const f32x4*)a.ln_mix_pre)[lane + 64 * j]; const f32x4 y = v[r][j] * rstd * g; u32x2 w; w.x = cvtpk(y.x, y.y); w.y = cvtpk(y.z, y.w); o8[64 * j] = w; } }
        }
    }
}

__device__ __forceinline__ void phase_mla_prep(const Args& a, int vcu, int G) {
    const int tid = threadIdx.x, lane = tid & 63, wave = __builtin_amdgcn_readfirstlane(tid >> 6);
    const int gw = vcu * 8 + wave, NGW = G * 8;
    unsigned char* ws = a.ws;
    const bf16_t* cq = (const bf16_t*)(ws + WS_CQ); const bf16_t* ckv = (const bf16_t*)(ws + WS_CKV); bf16_t* kr = (bf16_t*)(ws + WS_KR);
    float* rq = (float*)(ws + WS_RSTDQ); float* rkv = (float*)(ws + WS_RSTDKV);
    const float* tcos = (const float*)(ws + WS_TCOS); const float* tsin = (const float*)(ws + WS_TSIN);
    for (int m0 = gw * 4; m0 < T; m0 += NGW * 4) {
        unsigned wq[4][3], wk[4][2]; float x1[4], x2[4], cs[4], sn[4];
#pragma unroll
        for (int r = 0; r < 4; ++r) {
            const size_t m = (size_t)(m0 + r);
            const unsigned* p = (const unsigned*)(cq + m * 384); const unsigned* p2 = (const unsigned*)(ckv + m * 256);
#pragma unroll
            for (int j = 0; j < 3; ++j) wq[r][j] = p[lane + 64 * j];
#pragma unroll
            for (int j = 0; j < 2; ++j) wk[r][j] = p2[lane + 64 * j];
            x1[r] = bf2f(kr[m * 64 + (lane & 31)]); x2[r] = bf2f(kr[m * 64 + 32 + (lane & 31)]);
            cs[r] = tcos[m * 32 + (lane & 31)]; sn[r] = tsin[m * 32 + (lane & 31)];
        }
#pragma unroll
        for (int r = 0; r < 4; ++r) {
            const size_t m = (size_t)(m0 + r);
            float s = 0.f, s2 = 0.f;
#pragma unroll
            for (int j = 0; j < 3; ++j) { const float lo = bflo(wq[r][j]), hi = bfhi(wq[r][j]); s += lo * lo + hi * hi; }
#pragma unroll
            for (int j = 0; j < 2; ++j) { const float lo = bflo(wk[r][j]), hi = bfhi(wk[r][j]); s2 += lo * lo + hi * hi; }
            s = wave_sum(s); s2 = wave_sum(s2);
            if (lane == 0) { rq[m] = 1.f / sqrtf(s * (1.f / 384.f) + RMS_EPS); rkv[m] = 1.f / sqrtf(s2 * (1.f / 256.f) + RMS_EPS); }
            if (lane < 32) {
                const float y1 = x1[r] * cs[r] - x2[r] * sn[r], y2 = x2[r] * cs[r] + x1[r] * sn[r];
                kr[m * 64 + lane] = (bf16_t)(cvtpk(y1, 0.f) & 0xffffu); kr[m * 64 + 32 + lane] = (bf16_t)(cvtpk(y2, 0.f) & 0xffffu);
            }
        }
    }
}

__device__ __forceinline__ void phase_post_mix(const Args& a, int vcu, int G) {
    const int tid = threadIdx.x, lane = tid & 63, wave = __builtin_amdgcn_readfirstlane(tid >> 6);
    const int gw = vcu * 8 + wave, NGW = G * 8;
    bf16_t* H2 = (bf16_t*)(a.ws + WS_H2);
    for (int m0 = gw; m0 < T; m0 += RP * NGW) {
        f32x4 v[RP][4], xv[RP][4]; float sq[RP];
#pragma unroll
        for (int r = 0; r < RP; ++r) { const int m = m0 + r * NGW < T ? m0 + r * NGW : m0;
            const u32x2* t2r = (const u32x2*)((const bf16_t*)(a.ws + WS_T2) + (size_t)m * DM) + lane;
            const f32x4* xr = (const f32x4*)(a.x + (size_t)m * DM) + lane;
#pragma unroll
            for (int j = 0; j < 4; ++j) { const u32x2 w = t2r[64 * j]; v[r][j] = (f32x4){bflo(w.x), bfhi(w.x), bflo(w.y), bfhi(w.y)}; xv[r][j] = __builtin_nontemporal_load(xr + 64 * j); } }
#pragma unroll
        for (int r = 0; r < RP; ++r) { float s = 0.f;
#pragma unroll
            for (int j = 0; j < 4; ++j) s += (v[r][j].x * v[r][j].x + v[r][j].y * v[r][j].y) + (v[r][j].z * v[r][j].z + v[r][j].w * v[r][j].w);
            sq[r] = wave_sum(s); }
#pragma unroll
        for (int r = 0; r < RP; ++r) { const int m = m0 + r * NGW; if (m >= T) break;
            const float rstd = 1.f / sqrtf(sq[r] * (1.f / DM) + RMS_EPS);
            if (lane == 0) ((float*)(a.ws + WS_RSTDQ))[m] = rstd;
            float s2 = 0.f;
#pragma unroll
            for (int j = 0; j < 4; ++j) { const f32x4 g = ((const f32x4*)a.ln_mix_post)[lane + 64 * j]; v[r][j] = xv[r][j] + v[r][j] * rstd * g;
                s2 += (v[r][j].x * v[r][j].x + v[r][j].y * v[r][j].y) + (v[r][j].z * v[r][j].z + v[r][j].w * v[r][j].w); }
            const float rstd2 = 1.f / sqrtf(wave_sum(s2) * (1.f / DM) + RMS_EPS);
            u32x2* o8 = (u32x2*)(H2 + (size_t)m * DM) + lane;
#pragma unroll
            for (int j = 0; j < 4; ++j) { const f32x4 g = ((const f32x4*)a.ln_ffn_pre)[lane + 64 * j]; const f32x4 y = v[r][j] * rstd2 * g; u32x2 w; w.x = cvtpk(y.x, y.y); w.y = cvtpk(y.z, y.w); o8[64 * j] = w; } }
    }
}
__device__ __forceinline__ void phase_final(const Args& a, int vcu, int G) {
    const int tid = threadIdx.x, lane = tid & 63, wave = __builtin_amdgcn_readfirstlane(tid >> 6);
    const int gw = vcu * 8 + wave, NGW = G * 8;
    const bf16_t* F = (const bf16_t*)(a.ws + WS_F); const bf16_t* T2 = (const bf16_t*)(a.ws + WS_T2); const float* R1 = (const float*)(a.ws + WS_RSTDQ);
    for (int m0 = gw; m0 < T; m0 += RP * NGW) {
        f32x4 v[RP][4], xv[RP][4]; float sq[RP];
#pragma unroll
        for (int r = 0; r < RP; ++r) { const int m = m0 + r * NGW < T ? m0 + r * NGW : m0;
            const u32x2* fr = (const u32x2*)(F + (size_t)m * DM) + lane; const u32x2* tr = (const u32x2*)(T2 + (size_t)m * DM) + lane;
            const f32x4* xr = (const f32x4*)(a.x + (size_t)m * DM) + lane; const float r1 = R1[m];
#pragma unroll
            for (int j = 0; j < 4; ++j) { const u32x2 w = fr[64 * j]; v[r][j] = (f32x4){bflo(w.x), bfhi(w.x), bflo(w.y), bfhi(w.y)};
                const u32x2 w2 = tr[64 * j]; const f32x4 t2v = (f32x4){bflo(w2.x), bfhi(w2.x), bflo(w2.y), bfhi(w2.y)};
                const f32x4 g1 = ((const f32x4*)a.ln_mix_post)[lane + 64 * j]; xv[r][j] = __builtin_nontemporal_load(xr + 64 * j) + t2v * r1 * g1; } }
#pragma unroll
        for (int r = 0; r < RP; ++r) { float s = 0.f;
#pragma unroll
            for (int j = 0; j < 4; ++j) s += (v[r][j].x * v[r][j].x + v[r][j].y * v[r][j].y) + (v[r][j].z * v[r][j].z + v[r][j].w * v[r][j].w);
            sq[r] = wave_sum(s); }
#pragma unroll
        for (int r = 0; r < RP; ++r) { const int m = m0 + r * NGW; if (m >= T) break;
            f32x4* orow = (f32x4*)(a.out + (size_t)m * DM) + lane;
            const float rstd = 1.f / sqrtf(sq[r] * (1.f / DM) + RMS_EPS);
#pragma unroll
            for (int j = 0; j < 4; ++j) { const f32x4 g = ((const f32x4*)a.ln_ffn_post)[lane + 64 * j]; __builtin_nontemporal_store(xv[r][j] + v[r][j] * rstd * g, orow + 64 * j); } }
    }
}

#define MFMA32(a, b, c) __builtin_amdgcn_mfma_f32_32x32x16_bf16((a), (b), (c), 0, 0, 0)
template <int MODE>
__device__ __forceinline__ void attn_unit(LAS unsigned char* lds, const Args& a, int b, int h, int qb) {
    constexpr int KB_ = 16384, RB_ = MODE == 1 ? 8192 : 0, VB_ = 16384, STAGE = KB_ + RB_ + VB_;
    constexpr int NK = MODE == 0 ? 4 : 12;
    constexpr int NI = MODE == 0 ? 4 : 5;
    constexpr int QROWS = MODE == 0 ? 128 : 256;
    int tid = threadIdx.x; asm volatile("" : "+v"(tid));
    const int lane = tid & 63, hi = lane >> 5, ql = lane & 31;
    const int wid = __builtin_amdgcn_readfirstlane(tid >> 6);
    const int grp = MODE == 0 ? (wid & 3) : wid, which = MODE == 0 ? (wid >> 2) : 0;
    const int q0 = qb * QROWS;
    const int cw = (q0 + grp * 32) >> 6;
    const int nt = (q0 + QROWS) >> 6;
    const size_t bS = (size_t)b * SEQ;
    const size_t tq = bS + q0 + grp * 32 + ql;
    unsigned char* ws = a.ws;
    const bf16_t* Ksrc = MODE == 0 ? (const bf16_t*)(ws + WS_KA) : (const bf16_t*)(a.out);
    const bf16_t* Vsrc = MODE == 0 ? (const bf16_t*)(ws + WS_VAT) : (const bf16_t*)((unsigned char*)a.out + OUT_VBT);
    const char* kbase = (const char*)(Ksrc + bS * 1024 + h * 128);
    const char* vbase = (const char*)(Vsrc + (size_t)(h * 128) * T + bS);
    const char* rbase = (const char*)((const bf16_t*)(ws + WS_KR) + bS * 64);
    unsigned kso[2], vso[2], rso;
#pragma unroll
    for (int j = 0; j < 2; ++j) {
        { const int row = 4 * (wid * 2 + j) + (lane >> 4), c = (lane & 15) ^ (row & 15); kso[j] = (unsigned)(row * 2048 + c * 16); }
        { const int row = 8 * (wid * 2 + j) + (lane >> 3), c = (lane & 7) ^ ((row >> 1) & 7); vso[j] = (unsigned)(row * (T * 2) + c * 16); }
    }
    { const int row = 8 * wid + (lane >> 3), c = (lane & 7) ^ ((row >> 1) & 7); rso = (unsigned)(row * 128 + c * 16); }
#define ATT_DMA(kt, buf) do { const char* kb_ = kbase + (size_t)(kt) * (64 * 1024 * 2); const char* vb_ = vbase + (size_t)(kt) * 128; LAS unsigned char* sb_ = lds + (buf) * STAGE; \
        _Pragma("unroll") for (int j = 0; j < 2; ++j) { \
            __builtin_amdgcn_global_load_lds((const unsigned*)(kb_ + kso[j]), (LAS unsigned*)(sb_ + (wid * 2 + j) * 1024), 16, 0, 0); \
            __builtin_amdgcn_global_load_lds((const unsigned*)(vb_ + vso[j]), (LAS unsigned*)(sb_ + KB_ + RB_ + (wid * 2 + j) * 1024), 16, 0, 0); } \
        if (MODE == 1) __builtin_amdgcn_global_load_lds((const unsigned*)(rbase + (size_t)(kt) * (64 * 64 * 2) + rso), (LAS unsigned*)(sb_ + KB_ + wid * 1024), 16, 0, 0); } while (0)
    asm volatile("s_waitcnt vmcnt(0)" ::: "memory"); __builtin_amdgcn_s_barrier();
    ATT_DMA(0, 0); ATT_DMA(1, 1);
    bf16x8 qf[NK];
    if (MODE == 0) {
        const bf16_t* Q = (const bf16_t*)(ws + WS_QA) + tq * 1024 + h * 128 + which * 64 + 8 * hi;
#pragma unroll
        for (int ks = 0; ks < 4; ++ks) qf[ks] = *(const bf16x8*)(Q + 16 * ks);
    } else {
        const bf16_t* Q = (const bf16_t*)(ws + WS_QB) + tq * 1536 + 8 * hi;
#pragma unroll
        for (int ks = 0; ks < 8; ++ks) qf[ks] = *(const bf16x8*)(Q + h * 128 + 16 * ks);
#pragma unroll
        for (int ks = 8; ks < 12; ++ks) qf[ks] = *(const bf16x8*)(Q + 1024 + h * 64 + 16 * (ks - 8));
    }
    const int g_ = ql >> 3, hb_ = (ql >> 2) & 1, j_ = ql & 3;
    const int pim = 16 * (g_ >> 1) + 8 * hb_ + 4 * (g_ & 1) + j_;
    unsigned kl[MODE == 0 ? 4 : 8], rl[4], vl[4];
#pragma unroll
    for (int ks = 0; ks < (MODE == 0 ? 4 : 8); ++ks) kl[ks] = (unsigned)(pim * 256 + ((((MODE == 0 ? which * 8 : 0) + 2 * ks + hi) ^ (pim & 15)) * 16));
#pragma unroll
    for (int ks = 0; ks < 4; ++ks) { rl[ks] = (unsigned)(KB_ + pim * 128 + (((2 * ks + hi) ^ ((pim >> 1) & 7)) * 16)); vl[ks] = (unsigned)(KB_ + RB_ + ql * 128 + (((2 * ks + hi) ^ ((ql >> 1) & 7)) * 16)); }
    f32x16 o[4];
#pragma unroll
    for (int d = 0; d < 4; ++d)
#pragma unroll
        for (int i = 0; i < 16; ++i) o[d][i] = 0.f;
    float mrun = 0.f, lrun = 0.f;
    f32x16 negm;
#pragma unroll
    for (int i = 0; i < 16; ++i) negm[i] = 0.f;
    asm volatile("s_waitcnt vmcnt(0)" ::: "memory"); __builtin_amdgcn_s_barrier();
    int bcur = 0, bnext2 = 2;
    for (int kt = 0; kt < nt; ++kt) {
        if (kt + 2 < nt) ATT_DMA(kt + 2, bnext2);
        if (kt <= cw) {
            const LAS unsigned char* base = lds + bcur * STAGE;
            f32x16 s0, s1;
            bf16x8 ka[2][2];
#define ATT_LDK(bf, ks) do { if ((ks) < (MODE == 0 ? 4 : 8)) { ka[bf][0] = *(const LAS bf16x8*)(base + kl[(ks) & 7]); ka[bf][1] = *(const LAS bf16x8*)(base + kl[(ks) & 7] + 32 * 256); } \
        else { ka[bf][0] = *(const LAS bf16x8*)(base + rl[(ks) & 3]); ka[bf][1] = *(const LAS bf16x8*)(base + rl[(ks) & 3] + 32 * 128); } } while (0)
            ATT_LDK(0, 0);
#pragma unroll
            for (int ks = 0; ks < NK; ++ks) {
                if (ks + 1 < NK) ATT_LDK((ks + 1) & 1, ks + 1);
                __builtin_amdgcn_sched_barrier(0);

                if (ks == 0) { s0 = MFMA32(ka[0][0], qf[0], negm); s1 = MFMA32(ka[0][1], qf[0], negm); }
                else { s0 = MFMA32(ka[ks & 1][0], qf[ks], s0); s1 = MFMA32(ka[ks & 1][1], qf[ks], s1); }

                __builtin_amdgcn_sched_barrier(0);
            }
#undef ATT_LDK
            bf16x8 va[2][4];
#define ATT_LDVK(bf, kk) do { _Pragma("unroll") for (int d = 0; d < 4; ++d) va[bf][d] = *(const LAS bf16x8*)(base + vl[kk] + d * 32 * 128); } while (0)
            ATT_LDVK(0, 0);
            float mx0 = fmaxf(s0[0], s0[1]), mx1 = fmaxf(s1[0], s1[1]);
#pragma unroll
            for (int i = 2; i < 16; i += 2) { mx0 = fmaxf(fmaxf(mx0, s0[i]), s0[i + 1]); mx1 = fmaxf(fmaxf(mx1, s1[i]), s1[i + 1]); }
            const float mxs = xhalf_max(fmaxf(mx0, mx1));
            if (kt == 0) {
                mrun = mxs; s0 = s0 - mxs; s1 = s1 - mxs;
#pragma unroll
                for (int i = 0; i < 16; ++i) negm[i] = -mrun;
            } else if (__builtin_amdgcn_ballot_w64(mxs > 8.0f) != 0ull) {
                const float delta = fmaxf(mxs, 0.f);
                const float alpha = __builtin_amdgcn_exp2f(-delta);
                mrun += delta; lrun *= alpha; s0 = s0 - delta; s1 = s1 - delta;
#pragma unroll
                for (int d = 0; d < 4; ++d) o[d] = o[d] * alpha;
#pragma unroll
                for (int i = 0; i < 16; ++i) negm[i] = -mrun;
            }
            __builtin_amdgcn_sched_barrier(0);
            bf16x8 p[4]; float psum;
#define ATT_SLICE(g, S, off) do { _Pragma("unroll") for (int i = 0; i < 8; ++i) S[(off) + i] = __builtin_amdgcn_exp2f(S[(off) + i]); \
        u32x4 w_; w_.x = cvtpk(S[(off)], S[(off) + 1]); w_.y = cvtpk(S[(off) + 2], S[(off) + 3]); w_.z = cvtpk(S[(off) + 4], S[(off) + 5]); w_.w = cvtpk(S[(off) + 6], S[(off) + 7]); p[g] = __builtin_bit_cast(bf16x8, w_); \
        const float t_ = ((S[(off)] + S[(off) + 1]) + (S[(off) + 2] + S[(off) + 3])) + ((S[(off) + 4] + S[(off) + 5]) + (S[(off) + 6] + S[(off) + 7])); if ((g) == 0) psum = t_; else psum += t_; } while (0)
            ATT_SLICE(0, s0, 0);
#pragma unroll
            for (int g = 0; g < 4; ++g) {
                if (g + 1 < 4) ATT_LDVK((g + 1) & 1, g + 1);
#pragma unroll
                for (int d = 0; d < 4; ++d) o[d] = MFMA32(va[g & 1][d], p[g], o[d]);
                if (g == 0) ATT_SLICE(1, s0, 8);
                if (g == 1) ATT_SLICE(2, s1, 0);
                if (g == 2) ATT_SLICE(3, s1, 8);
#pragma unroll
                for (int i = 0; i < 4; ++i) { __builtin_amdgcn_sched_group_barrier(0x008, 1, 0); __builtin_amdgcn_sched_group_barrier(0x100, 1, 0); __builtin_amdgcn_sched_group_barrier(0x002, 5, 0); }
            }
            __builtin_amdgcn_sched_barrier(0);
            lrun += psum;
#undef ATT_SLICE
#undef ATT_LDVK
        }
        if (kt + 2 < nt) { if (MODE == 0) asm volatile("s_waitcnt vmcnt(4)" ::: "memory"); else asm volatile("s_waitcnt vmcnt(5)" ::: "memory"); }
        else asm volatile("s_waitcnt vmcnt(0)" ::: "memory");
        __builtin_amdgcn_s_barrier();
        bcur = (bcur == 2) ? 0 : bcur + 1; bnext2 = (bnext2 == 2) ? 0 : bnext2 + 1;
    }
#undef ATT_DMA
    lrun = xhalf_sum(lrun);
    const float inv = 1.f / lrun;
    if (MODE == 1) {
        bf16_t* O = (bf16_t*)(ws + WS_QB) + tq * 1536 + h * 128 + 4 * hi;
#pragma unroll
        for (int d = 0; d < 4; ++d)
#pragma unroll
            for (int g = 0; g < 4; ++g) {
                u32x2 w; w.x = cvtpk(o[d][4 * g] * inv, o[d][4 * g + 1] * inv); w.y = cvtpk(o[d][4 * g + 2] * inv, o[d][4 * g + 3] * inv);
                *(u32x2*)(O + 32 * d + 8 * g) = w;
            }
    } else {
        LAS float* X = (LAS float*)lds;
        const float lam = ((const float*)(ws + WS_CTL))[0];
        if (which == 1) {
#pragma unroll
            for (int d = 0; d < 4; ++d)
#pragma unroll
                for (int i = 0; i < 16; ++i) X[(d * 16 + i) * 256 + grp * 64 + lane] = o[d][i] * inv;
        }
        __syncthreads();
        if (which == 0) {
            float ssq = 0.f;
#pragma unroll
            for (int d = 0; d < 4; ++d)
#pragma unroll
                for (int i = 0; i < 16; ++i) { const float v = o[d][i] * inv - lam * X[(d * 16 + i) * 256 + grp * 64 + lane]; o[d][i] = v; ssq += v * v; }
            ssq = xhalf_sum(ssq);
            const float rstd = (1.f / sqrtf(ssq * (1.f / 128.f) + RMS_EPS)) * (1.f - LAMBDA_INIT);
            bf16_t* O = (bf16_t*)(ws + WS_QA) + tq * 1024 + h * 128 + 4 * hi;
#pragma unroll
            for (int d = 0; d < 4; ++d)
#pragma unroll
                for (int g = 0; g < 4; ++g) {
                    const f32x4 gn = *(const f32x4*)(a.da_subln + 32 * d + 8 * g + 4 * hi);
                    u32x2 w; w.x = cvtpk(o[d][4 * g] * rstd * gn.x, o[d][4 * g + 1] * rstd * gn.y); w.y = cvtpk(o[d][4 * g + 2] * rstd * gn.z, o[d][4 * g + 3] * rstd * gn.w);
                    *(u32x2*)(O + 32 * d + 8 * g) = w;
                }
        }
        __syncthreads();
    }
}

__device__ __forceinline__ void phase_attn(const Args& a, LAS unsigned char* lds, int vcu, int G) {
#pragma unroll 1
    for (int p2 = 2 * vcu; p2 < 2048; p2 += 2 * G) {
#pragma unroll 1
        for (int hf = 0; hf < 2; ++hf) {
            const int p = p2 >> 1, bh = p >> 5, pr = p & 31;
            attn_unit<0>(lds, a, bh >> 3, bh & 7, hf ? pr : 63 - pr);
        }
    }
    if (G == 256) {
        const int x = vcu >> 5, j = vcu & 31;
#pragma unroll 1
        for (int r = 0; r < 4; ++r) {
            const int bh = 4 * x + r;
            const int qb = (r & 1) ? (j < 16 ? j : 47 - j) : (j < 16 ? 31 - j : j - 16);
            attn_unit<1>(lds, a, bh >> 3, bh & 7, qb);
        }
    } else {
#pragma unroll 1
        for (int p2 = 2 * vcu; p2 < 1024; p2 += 2 * G) {
#pragma unroll 1
            for (int hf = 0; hf < 2; ++hf) {
                const int p = p2 >> 1, bh = p >> 4, pr = p & 15;
                attn_unit<1>(lds, a, bh >> 3, bh & 7, hf ? pr : 31 - pr);
            }
        }
    }
}

#define XB_TMO      128
#define XB_XCNT(j)  (256  + 64 * (j))
#define XB_XSUB(j)  (1280 + 64 * (j))
#define XB_XGEN(j)  (2304 + 64 * (j))
#define XB_TOP      3328
#define XB_TOPGEN   3392
#define XCD_BAR_WORDS 3456
#define XB_SPIN_CAP (1u << 22)
__device__ __forceinline__ unsigned xb_ld(unsigned* p)              { return __hip_atomic_load(p, __ATOMIC_RELAXED, __HIP_MEMORY_SCOPE_AGENT); }
__device__ __forceinline__ unsigned xb_add(unsigned* p, unsigned v) { return __hip_atomic_fetch_add(p, v, __ATOMIC_RELAXED, __HIP_MEMORY_SCOPE_AGENT); }
__device__ __forceinline__ unsigned xb_xcc_id() { return (unsigned)__builtin_amdgcn_s_getreg((3 << 11) | 20) & 0xFu; }
#define XB_SPIN(cond, bar) do { unsigned _sp = 0; while (cond) { __builtin_amdgcn_s_sleep(1); \
    if ((++_sp & 255u) == 0u) { if (xb_ld(&(bar)[XB_TMO])) break; if (_sp > XB_SPIN_CAP) { atomicAdd(&(bar)[XB_TMO], 1u); break; } } } } while (0)
struct XcdBarrier { unsigned* bar; unsigned x; volatile LAS unsigned* st; };
__device__ __forceinline__ XcdBarrier xcd_barrier_post(unsigned* bar, volatile LAS unsigned* st) {
    XcdBarrier b; b.bar = bar; b.x = xb_xcc_id(); b.st = st;
    if (threadIdx.x == 0) (void)xb_add(&bar[XB_XCNT(b.x)], 1u);
    return b;
}
__device__ __forceinline__ void xcd_barrier_complete(unsigned* bar, unsigned x, unsigned& nloc, unsigned& nx) {
    const unsigned G = gridDim.x * gridDim.y * gridDim.z;
    unsigned sum, cnt, mine, sp = 0u;
    for (;;) {
        sum = 0u; cnt = 0u; mine = 0u;
#pragma unroll
        for (unsigned j = 0; j < 16; ++j) { const unsigned c = xb_ld(&bar[XB_XCNT(j)]); sum += c; cnt += (c > 0u) ? 1u : 0u; mine = (j == x) ? c : mine; }
        if (sum == G) break;
        __builtin_amdgcn_s_sleep(1);
        if ((++sp & 255u) == 0u) { if (xb_ld(&bar[XB_TMO])) break; if (sp > XB_SPIN_CAP) { atomicAdd(&bar[XB_TMO], 1u); break; } }
    }
    nloc = mine > 0u ? mine : 1u; nx = cnt > 0u ? cnt : 1u;
}
__device__ __forceinline__ void xcd_barrier(const XcdBarrier& b) {
    asm volatile("s_waitcnt vmcnt(0)" ::: "memory");
    __syncthreads();
    if (threadIdx.x == 0) {
        unsigned* bar = b.bar;
        __builtin_amdgcn_s_waitcnt(0);
        unsigned nloc = b.st[0], nx = b.st[1];
        if (nloc == 0u) { xcd_barrier_complete(bar, b.x, nloc, nx); b.st[0] = nloc; b.st[1] = nx; }
        const unsigned old = xb_add(&bar[XB_XSUB(b.x)], 1u);
        const unsigned gen = old / nloc;
        if (old + 1u == (gen + 1u) * nloc) {
            __builtin_amdgcn_fence(__ATOMIC_RELEASE, "agent");
            asm volatile("s_waitcnt vmcnt(0)" ::: "memory");
            const unsigned og = xb_add(&bar[XB_TOP], 1u);
            const unsigned tg = og / nx;
            if (og + 1u == (tg + 1u) * nx) xb_add(&bar[XB_TOPGEN], 1u);
            else XB_SPIN(xb_ld(&bar[XB_TOPGEN]) == tg, bar);
            __builtin_amdgcn_fence(__ATOMIC_ACQUIRE, "agent");
            xb_add(&bar[XB_XGEN(b.x)], 1u);
            asm volatile("s_waitcnt vmcnt(0)" ::: "memory");
        } else {
            XB_SPIN(xb_ld(&bar[XB_XGEN(b.x)]) == gen, bar);
            __builtin_amdgcn_fence(__ATOMIC_ACQUIRE, "agent");
            asm volatile("s_waitcnt vmcnt(0)" ::: "memory");
        }
    }
    __syncthreads();
}

__global__ void __launch_bounds__(NTHR, 2) fwd_kernel(Args a) {
    extern __shared__ __attribute__((aligned(16))) unsigned char lds_raw[];
    LAS unsigned char* lds = (LAS unsigned char*)lds_raw;
    cg::grid_group grid = cg::this_grid();
    const int G = gridDim.x; const int bx = blockIdx.x;
    const int vcu = (G % 8 == 0) ? (bx % 8) * (G / 8) + bx / 8 : bx;
    unsigned char* ws = a.ws;
    const int lo = a.ph_lo, hi = a.ph_hi;
    volatile LAS unsigned* bst = (volatile LAS unsigned*)(lds + LDS_BYTES - 16);
    if (threadIdx.x < 4) bst[threadIdx.x] = 0u;
    __syncthreads();
    const XcdBarrier xbar = xcd_barrier_post((unsigned*)(ws + WS_BAR), bst);
#ifndef PHMASK
#define PHMASK 0xFFF
#endif
#define IN(k) (((PHMASK >> (k)) & 1) && lo <= (k) && (k) < hi)
#define SEAM(k) do { if (IN(k) && IN((k) + 1)) xcd_barrier(xbar); } while (0)
    if (lo < 0) grid.sync();
    bf16_t* Qa = (bf16_t*)(ws + WS_QA); bf16_t* Ka = (bf16_t*)(ws + WS_KA); bf16_t* Ga = (bf16_t*)(ws + WS_GA); bf16_t* Gb = (bf16_t*)(ws + WS_GB);
    bf16_t* VaT = (bf16_t*)(ws + WS_VAT); bf16_t* cq = (bf16_t*)(ws + WS_CQ); bf16_t* ckv = (bf16_t*)(ws + WS_CKV); bf16_t* kr = (bf16_t*)(ws + WS_KR);
    bf16_t* H = (bf16_t*)(ws + WS_H); bf16_t* Qb = (bf16_t*)(ws + WS_QB);
    bf16_t* Kb = (bf16_t*)((unsigned char*)a.out + OUT_KB); bf16_t* VbT = (bf16_t*)((unsigned char*)a.out + OUT_VBT);
    const float* tcos = (const float*)(ws + WS_TCOS); const float* tsin = (const float*)(ws + WS_TSIN);
    const float* rq = (const float*)(ws + WS_RSTDQ); const float* rkv = (const float*)(ws + WS_RSTDKV);
    pg8::StaticOrder S;

    if (IN(0)) { phase0(a, lds, vcu, G); __syncthreads(); }
    SEAM(0);
    if (IN(1)) {
        { pg8::Gemm g{H, (const bf16_t*)(ws + WS_W1T), T, N1, 1024, 1024, 1024}; S.init(T, N1, G, bx);
          EpiG1 E{Qa, Ka, Ga, Gb, cq, ckv, kr, tcos, tsin}; pg8::gemm_phase(lds, g, S, E); }
        { pg8::Gemm g{(const bf16_t*)(ws + WS_WVT), H, 1024, T, 1024, 1024, 1024}; S.init(1024, T, G, bx, G == 256 ? 128 : 0);
          EpiBf16<false, false> E{VaT, T, nullptr, nullptr}; pg8::gemm_phase(lds, g, S, E); }
    }
    SEAM(1);
    if (IN(2)) phase_mla_prep(a, vcu, G);
    SEAM(2);
    if (IN(3)) {
        { pg8::Gemm g{cq, (const bf16_t*)(ws + WS_WUQT), T, 1536, 384, 384, 384}; S.init(T, 1536, G, bx);
          EpiQb E{Qb, rq, tcos, tsin}; pg8::gemm_phase(lds, g, S, E); }
        { pg8::Gemm g{ckv, (const bf16_t*)(ws + WS_WUKT), T, 1024, 256, 256, 256}; S.init(T, 1024, G, bx);
          EpiBf16<true, false> E{Kb, 1024, rkv, nullptr}; pg8::gemm_phase(lds, g, S, E); }
        { pg8::Gemm g{(const bf16_t*)(ws + WS_WUVT), ckv, 1024, T, 256, 256, 256}; S.init(1024, T, G, bx);
          EpiBf16<false, true> E{VbT, T, nullptr, rkv}; pg8::gemm_phase(lds, g, S, E); }
    }
    SEAM(3);
    if (IN(4)) phase_attn(a, lds, vcu, G);
    SEAM(4);
    if (IN(5)) { pg8::Gemm g{Qa, (const bf16_t*)(ws + WS_WPAT), T, 1024, 1024, 1024, 1024}; S.init(T, 1024, G, bx);
        EpiMix<0> E{Ga, nullptr, (bf16_t*)a.out}; pg8::gemm_phase(lds, g, S, E); }
    if (IN(6)) { pg8::Gemm g{Qb, (const bf16_t*)(ws + WS_WPBT), T, 1024, 1024, 1536, 1024}; S.init(T, 1024, G, bx);
        EpiMix<1> E{Gb, (const bf16_t*)a.out, (bf16_t*)(ws + WS_MERGED)}; pg8::gemm_phase(lds, g, S, E); }
    SEAM(6);
    if (IN(7)) { pg8::Gemm g{(const bf16_t*)(ws + WS_MERGED), (const bf16_t*)(ws + WS_WOT), T, 1024, 1024, 1024, 1024}; S.init(T, 1024, G, bx);
        EpiMix<2> E{nullptr, nullptr, (bf16_t*)(ws + WS_T2)}; pg8::gemm_phase(lds, g, S, E); }
    SEAM(7);
    if (IN(8)) phase_post_mix(a, vcu, G);
    SEAM(8);
    if (IN(9)) { pg8::Gemm g{(const bf16_t*)(ws + WS_H2), (const bf16_t*)(ws + WS_WGUT), T, 5632, 1024, 1024, 1024}; S.init(T, 5632, G, bx);
        EpiSwiglu E{(bf16_t*)(ws + WS_U)}; pg8::gemm_phase(lds, g, S, E); }
    SEAM(9);
    if (IN(10)) { pg8::Gemm g{(const bf16_t*)(ws + WS_U), (const bf16_t*)(ws + WS_WDT), T, 1024, DFF, DFF, DFF}; S.init(T, 1024, G, bx);
        EpiMix<2> E{nullptr, nullptr, (bf16_t*)(ws + WS_F)}; pg8::gemm_phase(lds, g, S, E); }
    SEAM(10);
    if (IN(11)) phase_final(a, vcu, G);
#undef IN
#undef SEAM
}

constexpr int N_PHASES = 12;
#ifndef MK_MULTI
#define MK_MULTI 0
#endif

extern "C" void kernel_launch(void* const* d_in, const int* in_sizes, int n_in, void* d_out, int out_size, void* d_ws, size_t ws_size, hipStream_t stream) {
    static int grid = 0;
    if (grid == 0) {
        if (n_in != 22 || in_sizes[0] != T * DM || out_size != T * DM || ws_size < WS_END) { fprintf(stderr, "kernel_launch: unexpected shapes / workspace (%zu)\n", ws_size); grid = -1; return; }
        int dev = 0, cus = 0, per_cu = 0;
        (void)hipGetDevice(&dev);
        (void)hipDeviceGetAttribute(&cus, hipDeviceAttributeMultiprocessorCount, dev);
        (void)hipFuncSetAttribute((const void*)fwd_kernel, hipFuncAttributeMaxDynamicSharedMemorySize, LDS_BYTES);
        (void)hipOccupancyMaxActiveBlocksPerMultiprocessor(&per_cu, (const void*)fwd_kernel, NTHR, LDS_BYTES);
        if (per_cu < 1) per_cu = 1;
        grid = cus * per_cu;
        (void)hipGetLastError();
    }
    if (grid < 0) return;
    (void)hipMemsetAsync((unsigned char*)d_ws + WS_BAR, 0, WS_BAR_BYTES, stream);
    Args a;
    memset(&a, 0, sizeof(a));
    a.x = (const float*)d_in[0]; a.pos = (const int*)d_in[1]; a.ln_mix_pre = (const float*)d_in[2]; a.w_in = (const float*)d_in[3];
    a.lq1 = (const float*)d_in[4]; a.lk1 = (const float*)d_in[5]; a.lq2 = (const float*)d_in[6]; a.lk2 = (const float*)d_in[7];
    a.da_subln = (const float*)d_in[8]; a.q_a_norm = (const float*)d_in[9]; a.w_uq = (const float*)d_in[10]; a.kv_a_norm = (const float*)d_in[11]; a.w_ukv = (const float*)d_in[12];
    a.w_pa = (const float*)d_in[13]; a.w_pb = (const float*)d_in[14]; a.w_o = (const float*)d_in[15]; a.ln_mix_post = (const float*)d_in[16]; a.ln_ffn_pre = (const float*)d_in[17];
    a.w_g = (const float*)d_in[18]; a.w_u = (const float*)d_in[19]; a.w_d = (const float*)d_in[20]; a.ln_ffn_post = (const float*)d_in[21];
    a.out = (float*)d_out; a.ws = (unsigned char*)d_ws;
    for (int i = 0; i < 32; ++i) a.invf[i] = 1.0 / pow(10000.0, (double)i * (2.0 / 64.0));
#if MK_MULTI
    for (int ph = 0; ph < N_PHASES; ++ph) {
        a.ph_lo = ph; a.ph_hi = ph + 1;
        hipLaunchKernelGGL(fwd_kernel, dim3(grid), dim3(NTHR), LDS_BYTES, stream, a);
    }
#else
    a.ph_lo = 0; a.ph_hi = N_PHASES;
    void* args[] = {&a};
    hipError_t e = hipLaunchCooperativeKernel((const void*)fwd_kernel, dim3(grid), dim3(NTHR), args, LDS_BYTES, stream);
    if (e != hipSuccess) fprintf(stderr, "cooperative launch failed: %s (grid %d)\n", hipGetErrorString(e), grid);
#endif
}
```

```cpp
#include <hip/hip_runtime.h>
#include <hip/hip_cooperative_groups.h>
#include <cstdio>
#include <cstdint>
#include <cmath>
#include <cstring>
namespace cg = cooperative_groups;

#define LAS __attribute__((address_space(3)))
typedef unsigned short bf16_t;
typedef short bf16x8 __attribute__((ext_vector_type(8)));
typedef float f32x4 __attribute__((ext_vector_type(4)));
typedef float f32x16 __attribute__((ext_vector_type(16)));
typedef unsigned u32x4 __attribute__((ext_vector_type(4)));
typedef unsigned u32x2 __attribute__((ext_vector_type(2)));
typedef float f32x2_t __attribute__((ext_vector_type(2)));
typedef __bf16 bf16x2_t __attribute__((ext_vector_type(2)));

constexpr int BATCH = 4, SEQ = 8192, DM = 1024, T = BATCH * SEQ;
constexpr int DFF = 2816;
constexpr int IN_COLS = 5824;
constexpr int N1 = 4864;
constexpr float RMS_EPS = 1e-6f;
constexpr float LAMBDA_INIT = 0.2f;
constexpr int NTHR = 512;
constexpr float C2_DA = 0.125f * 1.4426950408889634f, C2_MLA = 0.07216878364870322f * 1.4426950408889634f;
constexpr int RP = 4;

constexpr size_t MiB = 1u << 20;
constexpr size_t WS_CTL = 0;
constexpr size_t WS_RSTDQ = 256 * 1024, WS_RSTDKV = 512 * 1024;
constexpr size_t WS_BAR = 64 * 1024, WS_BAR_BYTES = 16 * 1024;
constexpr size_t WS_W1T = 1 * MiB;
constexpr size_t WS_WVT = WS_W1T + (size_t)N1 * 1024 * 2;
constexpr size_t WS_WUQT = WS_WVT + (size_t)1024 * 1024 * 2;
constexpr size_t WS_WUKT = WS_WUQT + (size_t)1536 * 384 * 2;
constexpr size_t WS_WUVT = WS_WUKT + (size_t)1024 * 256 * 2;
constexpr size_t WS_WPAT = WS_WUVT + (size_t)1024 * 256 * 2;
constexpr size_t WS_WPBT = WS_WPAT + (size_t)1024 * 1024 * 2;
constexpr size_t WS_WOT = WS_WPBT + (size_t)1024 * 1024 * 2;
constexpr size_t WS_WGUT = WS_WOT + (size_t)1024 * 1024 * 2;
constexpr size_t WS_WDT = WS_WGUT + (size_t)5632 * 1024 * 2;
constexpr size_t WS_WEND = WS_WDT + (size_t)1024 * 2816 * 2;
static_assert(WS_WEND <= 38 * MiB, "weights");
constexpr size_t WS_TCOS = 38 * MiB, WS_TSIN = 42 * MiB;
constexpr size_t WS_QA = 46 * MiB, WS_KA = 110 * MiB, WS_GA = 174 * MiB, WS_GB = 238 * MiB, WS_VAT = 302 * MiB;
constexpr size_t WS_CQ = 366 * MiB, WS_CKV = 390 * MiB, WS_KR = 406 * MiB, WS_H = 410 * MiB, WS_QB = 410 * MiB;
constexpr size_t WS_END = 506 * MiB;
constexpr size_t WS_MERGED = WS_KA, WS_H2 = WS_QA, WS_U = WS_GA, WS_F = WS_QA, WS_T2 = WS_QB;
constexpr size_t OUT_KB = 0, OUT_VBT = 64 * MiB;

constexpr int LDS_BYTES = 135168;

__device__ __forceinline__ unsigned cvtpk(float lo, float hi) { f32x2_t v = {lo, hi}; bf16x2_t b = __builtin_convertvector(v, bf16x2_t); return __builtin_bit_cast(unsigned, b); }
__device__ __forceinline__ float bf2f(unsigned short u) { return __uint_as_float(((unsigned)u) << 16); }
__device__ __forceinline__ float bflo(unsigned u) { return __uint_as_float(u << 16); }
__device__ __forceinline__ float bfhi(unsigned u) { return __uint_as_float(u & 0xffff0000u); }
__device__ __forceinline__ float wave_sum(float v) {
#pragma unroll
    for (int o = 1; o < 64; o <<= 1) v += __shfl_xor(v, o);
    return v;
}
__device__ __forceinline__ float xhalf(float v) {
    return __shfl_xor(v, 32);
}
__device__ __forceinline__ float xhalf_max(float v) {
    auto rr = __builtin_amdgcn_permlane32_swap(__float_as_uint(v), __float_as_uint(v), false, false);
    return fmaxf(__uint_as_float(rr[0]), __uint_as_float(rr[1]));
}
__device__ __forceinline__ float xhalf_sum(float v) {
    auto rr = __builtin_amdgcn_permlane32_swap(__float_as_uint(v), __float_as_uint(v), false, false);
    return __uint_as_float(rr[0]) + __uint_as_float(rr[1]);
}
__device__ __forceinline__ void store8(bf16_t* p, f32x4 a, f32x4 b) {
    u32x4 w; w.x = cvtpk(a[0], a[1]); w.y = cvtpk(a[2], a[3]); w.z = cvtpk(b[0], b[1]); w.w = cvtpk(b[2], b[3]);
    *(u32x4*)p = w;
}

namespace pg8 {
constexpr int BM = 256, BK = 64, HALF = 128, HTB = HALF * BK * 2, STAGE_BYTES = 8 * HTB, NXCD = 8, WGM = 4;
__host__ __device__ __forceinline__ int lds_byte(int r, int c) { const int st = (r >> 4) * 2 + (c >> 5), rr = r & 15, cc = c & 31, ob = rr * 64 + cc * 2; return st * 1024 + (ob ^ (((ob >> 9) & 1) << 5)); }
__host__ __device__ __forceinline__ void stage_rc(int b, int& R, int& C) { const int st = b / 1024, sb = b % 1024, swz = sb ^ (((sb >> 9) & 1) << 5); R = (st >> 1) * 16 + swz / 64; C = (st & 1) * 32 + (swz % 64) / 2; }
__host__ __device__ __forceinline__ int perm32(int rho) { const int n = rho >> 4, i = rho & 15; return 8 * (i >> 2) + 4 * n + (i & 3); }

struct Unit { int pm, pn; };
struct Gemm { const bf16_t* A; const bf16_t* Bt; int M, N, K, lda, ldb; };

struct StaticOrder {
    int nM, nN, nwg, G, c, bal;
    __device__ void init(int M, int N, int G_, int c_, int bal_ = 0) { nM = M / BM; nN = N / BM; nwg = nM * nN; G = G_; c = c_; bal = bal_; }
    __device__ bool next(int i, Unit& u) const {
        long L;
        if (bal > 0) { if (c < bal) { if (i > 0) return false; L = c; } else { if (i > 2) return false; L = bal + 3 * (c - bal) + i; } }
        else L = (long)i * G + c;
        if (L >= nwg) return false;
        int wgid = (int)L; { const int q = nwg / NXCD, r = nwg % NXCD, xcd = wgid % NXCD, off = wgid / NXCD; wgid = (xcd < r ? xcd * (q + 1) : r * (q + 1) + (xcd - r) * q) + off; }
        const int nig = WGM * nN, gid = wgid / nig, fm = gid * WGM, gsz = (nM - fm) < WGM ? (nM - fm) : WGM;
        u.pm = fm + ((wgid % nig) % gsz); u.pn = (wgid % nig) / gsz; return true;
    }
};

template <class Epi>
__device__ __forceinline__ void gemm_phase(LAS unsigned char* lds, const Gemm g, const StaticOrder& S, const Epi& E) {
    const int tid = threadIdx.x, wid = __builtin_amdgcn_readfirstlane(tid >> 6), lane = tid & 63, wr = wid >> 2, wc = wid & 3, fr = lane & 15, fq = lane >> 4;
    int K = g.K; asm volatile("" : "+s"(K)); const int nt = K / BK;
    unsigned voffA[2], voffB[2];
#pragma unroll
    for (int i = 0; i < 2; ++i) { int R, C; stage_rc(tid * 16 + i * 8192, R, C); const int Rb = (R & ~31) + perm32(R & 31);
        voffA[i] = (unsigned)(R * g.lda + C) * 2u; voffB[i] = (unsigned)(Rb * g.ldb + C) * 2u; }
    const size_t kstep = (size_t)(BK * 2);
    const size_t hstepA = (size_t)HALF * g.lda * 2, hstepB = (size_t)HALF * g.ldb * 2;
    const size_t tstepA = 2 * hstepA, tstepB = 2 * hstepB;
    const unsigned ldsw = (unsigned)wid * 1024u;
    const int aoff = lds_byte(wr * 64 + fr, fq * 8), boff = lds_byte(wc * 32 + fr, fq * 8);
#define PG8_SA(b, h) (((b) * 2 + (h)) * HTB)
#define PG8_SB(b, h) ((4 + (b) * 2 + (h)) * HTB)
#define PG8_STAGE(bufoff, gbase, voff) do { _Pragma("unroll") for (int _i = 0; _i < 2; ++_i) \
        __builtin_amdgcn_global_load_lds((const unsigned*)((const char*)(gbase) + (voff)[_i]), (LAS unsigned*)(lds + (bufoff) + ldsw + _i * 8192), 16, 0, 0); } while (0)
#define PG8_LDA(dst, b, h) do { _Pragma("unroll") for (int m = 0; m < 4; ++m) _Pragma("unroll") for (int k = 0; k < 2; ++k) dst[m][k] = *(const LAS bf16x8*)(lds + PG8_SA(b, h) + aoff + m * 2048 + k * 1024); } while (0)
#define PG8_LDB(dst, b, h) do { _Pragma("unroll") for (int n = 0; n < 2; ++n) _Pragma("unroll") for (int k = 0; k < 2; ++k) dst[n][k] = *(const LAS bf16x8*)(lds + PG8_SB(b, h) + boff + n * 2048 + k * 1024); } while (0)
#define PG8_MMA(ai, bj, At, Bt) do { __builtin_amdgcn_s_setprio(1); _Pragma("unroll") for (int m = 0; m < 4; ++m) _Pragma("unroll") for (int n = 0; n < 2; ++n) _Pragma("unroll") for (int k = 0; k < 2; ++k) \
        acc[ai][bj][m][n] = __builtin_amdgcn_mfma_f32_16x16x32_bf16(Bt[n][k], At[m][k], acc[ai][bj][m][n], 0, 0, 0); __builtin_amdgcn_s_setprio(0); } while (0)
#define PG8_WAIT_V(n) asm volatile("s_waitcnt vmcnt(" #n ")" ::: "memory")
#define PG8_WAIT_L(n) asm volatile("s_waitcnt lgkmcnt(" #n ")" ::: "memory")
#define PG8_BAR __builtin_amdgcn_s_barrier()
#define PG8_SCHED __builtin_amdgcn_sched_barrier(0)
    Unit cur, nxt; int ui = 0;
    if (!S.next(0, cur)) return;
    f32x4 acc[2][2][4][2];
#pragma unroll
    for (int a = 0; a < 2; ++a)
#pragma unroll
        for (int b = 0; b < 2; ++b)
#pragma unroll
            for (int m = 0; m < 4; ++m)
#pragma unroll
                for (int n = 0; n < 2; ++n) acc[a][b][m][n] = (f32x4){0.f, 0.f, 0.f, 0.f};
    bf16x8 At[4][2], B0[2][2], B1[2][2];
    const char* cA = (const char*)g.A + (size_t)cur.pm * tstepA; const char* cB = (const char*)g.Bt + (size_t)cur.pn * tstepB;
    PG8_STAGE(PG8_SB(0, 0), cB, voffB); PG8_STAGE(PG8_SB(0, 1), cB + hstepB, voffB); PG8_STAGE(PG8_SA(0, 0), cA, voffA); PG8_STAGE(PG8_SA(0, 1), cA + hstepA, voffA);
    if (wr == 1) PG8_BAR;
    PG8_WAIT_V(2); PG8_BAR;
    PG8_STAGE(PG8_SB(1, 0), cB + kstep, voffB); PG8_STAGE(PG8_SA(1, 0), cA + kstep, voffA); PG8_STAGE(PG8_SB(1, 1), cB + hstepB + kstep, voffB);
    PG8_WAIT_V(6); PG8_BAR;
    for (;;) {
        const bool has_next = S.next(ui + 1, nxt);
        const char* nA = has_next ? (const char*)g.A + (size_t)nxt.pm * tstepA : cA; const char* nB = has_next ? (const char*)g.Bt + (size_t)nxt.pn * tstepB : cB;
#pragma unroll 1
        for (int t = 0; t < nt; t += 2) {
            const bool last = (t == nt - 2);
            const char* a1 = cA + (size_t)(t + 1) * kstep;
            const char* a2 = last ? nA : cA + (size_t)(t + 2) * kstep; const char* b2 = last ? nB : cB + (size_t)(t + 2) * kstep;
            const char* a3 = a2 + kstep; const char* b3 = b2 + kstep;
            PG8_LDB(B0, 0, 0); PG8_LDB(B1, 0, 1); PG8_SCHED; PG8_LDA(At, 0, 0); PG8_STAGE(PG8_SA(1, 1), a1 + hstepA, voffA);
            PG8_WAIT_V(8); PG8_WAIT_L(0); PG8_BAR; PG8_MMA(0, 0, At, B0); PG8_MMA(0, 1, At, B1); PG8_BAR; PG8_SCHED;
            PG8_LDA(At, 0, 1); PG8_STAGE(PG8_SB(0, 0), b2, voffB); PG8_STAGE(PG8_SB(0, 1), b2 + hstepB, voffB); PG8_STAGE(PG8_SA(0, 0), a2, voffA);
            PG8_WAIT_V(8); PG8_WAIT_L(0); PG8_BAR; PG8_MMA(1, 0, At, B0); PG8_MMA(1, 1, At, B1); PG8_BAR; PG8_SCHED;
            PG8_LDB(B0, 1, 0); PG8_LDB(B1, 1, 1); PG8_SCHED; PG8_LDA(At, 1, 0); PG8_STAGE(PG8_SA(0, 1), a2 + hstepA, voffA);
            PG8_WAIT_V(8); PG8_WAIT_L(0); PG8_BAR; PG8_MMA(0, 0, At, B0); PG8_MMA(0, 1, At, B1); PG8_BAR; PG8_SCHED;
            PG8_LDA(At, 1, 1); PG8_STAGE(PG8_SB(1, 0), b3, voffB); PG8_STAGE(PG8_SB(1, 1), b3 + hstepB, voffB); PG8_STAGE(PG8_SA(1, 0), a3, voffA);
            PG8_WAIT_V(8); PG8_WAIT_L(0); PG8_BAR; PG8_MMA(1, 0, At, B0); PG8_MMA(1, 1, At, B1); PG8_BAR; PG8_SCHED;
        }
        if (wr == 0) PG8_BAR;
        E(acc, cur, wr, wc, fr, fq);
        if (!has_next) break;
#pragma unroll
        for (int a = 0; a < 2; ++a)
#pragma unroll
            for (int b = 0; b < 2; ++b)
#pragma unroll
                for (int m = 0; m < 4; ++m)
#pragma unroll
                    for (int n = 0; n < 2; ++n) acc[a][b][m][n] = (f32x4){0.f, 0.f, 0.f, 0.f};
        cur = nxt; cA = nA; cB = nB; ++ui;
        if (wr == 1) PG8_BAR;
    }
    PG8_WAIT_V(0);
    PG8_BAR;
#undef PG8_SA
#undef PG8_SB
#undef PG8_STAGE
#undef PG8_LDA
#undef PG8_LDB
#undef PG8_MMA
#undef PG8_WAIT_V
#undef PG8_WAIT_L
#undef PG8_BAR
#undef PG8_SCHED
}
}

typedef f32x4 Acc[2][2][4][2];
using pg8::Unit;

struct EpiG1 {
    bf16_t *Qa, *Ka, *Ga, *Gb, *cq, *ckv, *kr; const float *tcos, *tsin;
    __device__ __forceinline__ void operator()(const Acc& acc, const Unit& u, int wr, int wc, int fr, int fq) const {
        const int pn = u.pn, row0 = u.pm * 256 + wr * 64 + fr;
        if (pn < 8) {
            bf16_t* dst = pn < 4 ? Qa : Ka; const int colbase = (pn & 3) * 256 + wc * 64 + 8 * fq;
            const float qs = pn < 4 ? C2_DA : 1.f;
            f32x4 tc[2][2], ts[2][2];
            { const size_t r = (size_t)row0; tc[0][0] = *(const f32x4*)(tcos + r * 32 + 8 * fq); tc[0][1] = *(const f32x4*)(tcos + r * 32 + 8 * fq + 4);
              ts[0][0] = *(const f32x4*)(tsin + r * 32 + 8 * fq); ts[0][1] = *(const f32x4*)(tsin + r * 32 + 8 * fq + 4); }
#pragma unroll
            for (int it = 0; it < 8; ++it) {
                const int ai = it >> 2, m = it & 3;
                const size_t r = (size_t)(row0 + ai * 128 + m * 16);
                if (it + 1 < 8) { const size_t rn = (size_t)(row0 + ((it + 1) >> 2) * 128 + ((it + 1) & 3) * 16);
                    tc[(it + 1) & 1][0] = *(const f32x4*)(tcos + rn * 32 + 8 * fq); tc[(it + 1) & 1][1] = *(const f32x4*)(tcos + rn * 32 + 8 * fq + 4);
                    ts[(it + 1) & 1][0] = *(const f32x4*)(tsin + rn * 32 + 8 * fq); ts[(it + 1) & 1][1] = *(const f32x4*)(tsin + rn * 32 + 8 * fq + 4); }
                const f32x4 c0 = tc[it & 1][0], c1 = tc[it & 1][1], s0 = ts[it & 1][0], s1 = ts[it & 1][1];
                const f32x4 a0 = acc[ai][0][m][0], a1 = acc[ai][0][m][1], b0 = acc[ai][1][m][0], b1 = acc[ai][1][m][1];
                store8(dst + r * 1024 + colbase, (a0 * c0 - b0 * s0) * qs, (a1 * c1 - b1 * s1) * qs);
                store8(dst + r * 1024 + colbase + 32, (b0 * c0 + a0 * s0) * qs, (b1 * c1 + a1 * s1) * qs);
                asm volatile("" ::: "memory");
            }
        } else if (pn < 16) {
            bf16_t* dst = pn < 12 ? Ga : Gb; const int colbase = ((pn - 8) & 3) * 256 + wc * 32 + 8 * fq;
#pragma unroll
            for (int ai = 0; ai < 2; ++ai)
#pragma unroll
                for (int m = 0; m < 4; ++m) {
                    const size_t r = (size_t)(row0 + ai * 128 + m * 16);
#pragma unroll
                    for (int bj = 0; bj < 2; ++bj) {
                        f32x4 v0 = acc[ai][bj][m][0], v1 = acc[ai][bj][m][1];
#pragma unroll
                        for (int e = 0; e < 4; ++e) { v0[e] = __builtin_amdgcn_rcpf(1.f + __builtin_amdgcn_exp2f(v0[e] * -1.4426950408889634f)); v1[e] = __builtin_amdgcn_rcpf(1.f + __builtin_amdgcn_exp2f(v1[e] * -1.4426950408889634f)); }
                        store8(dst + r * 1024 + colbase + bj * 128, v0, v1);
                    }
                }
        } else {
#pragma unroll
            for (int bj = 0; bj < 2; ++bj) {
                const int hidx = 2 * (pn - 16) + bj;
                bf16_t* dst; int ld, col;
                if (hidx < 3) { dst = cq; ld = 384; col = hidx * 128 + wc * 32 + 8 * fq; }
                else if (hidx < 5) { dst = ckv; ld = 256; col = (hidx - 3) * 128 + wc * 32 + 8 * fq; }
                else { dst = kr; ld = 64; col = wc * 32 + 8 * fq; if (wc >= 2) continue; }
#pragma unroll
                for (int ai = 0; ai < 2; ++ai)
#pragma unroll
                    for (int m = 0; m < 4; ++m) {
                        const size_t r = (size_t)(row0 + ai * 128 + m * 16);
                        store8(dst + r * ld + col, acc[ai][bj][m][0], acc[ai][bj][m][1]);
                    }
            }
        }
    }
};
template <bool RS, bool CS> struct EpiBf16 {
    bf16_t* O; int ld; const float* rs; const float* cs;
    __device__ __forceinline__ void operator()(const Acc& acc, const Unit& u, int wr, int wc, int fr, int fq) const {
        const int row0 = u.pm * 256 + wr * 64 + fr, col0 = u.pn * 256 + wc * 32 + 8 * fq;
        float rsv[8];
#pragma unroll
        for (int it = 0; it < 8; ++it) rsv[it] = RS ? rs[row0 + (it >> 2) * 128 + (it & 3) * 16] : 1.f;
#pragma unroll
        for (int bj = 0; bj < 2; ++bj) {
            f32x4 cv0 = (f32x4){1.f, 1.f, 1.f, 1.f}, cv1 = cv0;
            if (CS) { cv0 = *(const f32x4*)(cs + col0 + bj * 128); cv1 = *(const f32x4*)(cs + col0 + bj * 128 + 4); }
#pragma unroll
            for (int ai = 0; ai < 2; ++ai)
#pragma unroll
                for (int m = 0; m < 4; ++m) {
                    const size_t r = (size_t)(row0 + ai * 128 + m * 16);
                    f32x4 v0 = acc[ai][bj][m][0], v1 = acc[ai][bj][m][1];
                    if (CS) { v0 = v0 * cv0; v1 = v1 * cv1; }
                    if (RS) { const float sc = rsv[ai * 4 + m]; v0 = v0 * sc; v1 = v1 * sc; }
                    store8(O + r * ld + col0 + bj * 128, v0, v1);
                    asm volatile("" ::: "memory");
                }
        }
    }
};
struct EpiQb {
    bf16_t* Qb; const float* rs; const float *tcos, *tsin;
    __device__ __forceinline__ void operator()(const Acc& acc, const Unit& u, int wr, int wc, int fr, int fq) const {
        const int pn = u.pn, row0 = u.pm * 256 + wr * 64 + fr;
        float rsv[8];
#pragma unroll
        for (int it = 0; it < 8; ++it) rsv[it] = rs[row0 + (it >> 2) * 128 + (it & 3) * 16] * C2_MLA;
        if (pn < 4) {
#pragma unroll
            for (int it = 0; it < 8; ++it) {
                const int ai = it >> 2, m = it & 3; const size_t r = (size_t)(row0 + ai * 128 + m * 16); const float sc = rsv[it];
#pragma unroll
                for (int bj = 0; bj < 2; ++bj)
                    store8(Qb + r * 1536 + pn * 256 + bj * 128 + wc * 32 + 8 * fq, acc[ai][bj][m][0] * sc, acc[ai][bj][m][1] * sc);
                asm volatile("" ::: "memory");
            }
        } else {
            const int colbase = 1024 + (4 * (pn - 4) + wc) * 64 + 8 * fq;
            f32x4 tc[2][2], ts[2][2];
            { const size_t r = (size_t)row0; tc[0][0] = *(const f32x4*)(tcos + r * 32 + 8 * fq); tc[0][1] = *(const f32x4*)(tcos + r * 32 + 8 * fq + 4);
              ts[0][0] = *(const f32x4*)(tsin + r * 32 + 8 * fq); ts[0][1] = *(const f32x4*)(tsin + r * 32 + 8 * fq + 4); }
#pragma unroll
            for (int it = 0; it < 8; ++it) {
                const int ai = it >> 2, m = it & 3; const size_t r = (size_t)(row0 + ai * 128 + m * 16); const float sc = rsv[it];
                if (it + 1 < 8) { const size_t rn = (size_t)(row0 + ((it + 1) >> 2) * 128 + ((it + 1) & 3) * 16);
                    tc[(it + 1) & 1][0] = *(const f32x4*)(tcos + rn * 32 + 8 * fq); tc[(it + 1) & 1][1] = *(const f32x4*)(tcos + rn * 32 + 8 * fq + 4);
                    ts[(it + 1) & 1][0] = *(const f32x4*)(tsin + rn * 32 + 8 * fq); ts[(it + 1) & 1][1] = *(const f32x4*)(tsin + rn * 32 + 8 * fq + 4); }
                const f32x4 c0 = tc[it & 1][0], c1 = tc[it & 1][1], s0 = ts[it & 1][0], s1 = ts[it & 1][1];
                const f32x4 a0 = acc[ai][0][m][0] * sc, a1 = acc[ai][0][m][1] * sc, b0 = acc[ai][1][m][0] * sc, b1 = acc[ai][1][m][1] * sc;
                store8(Qb + r * 1536 + colbase, a0 * c0 - b0 * s0, a1 * c1 - b1 * s1);
                store8(Qb + r * 1536 + colbase + 32, b0 * c0 + a0 * s0, b1 * c1 + a1 * s1);
                asm volatile("" ::: "memory");
            }
        }
    }
};
template <int MODE> struct EpiMix {
    const bf16_t* G; const bf16_t* T1; bf16_t* O;
    __device__ __forceinline__ void operator()(const Acc& acc, const Unit& u, int wr, int wc, int fr, int fq) const {
        const int row0 = u.pm * 256 + wr * 64 + fr, col0 = u.pn * 256 + wc * 32 + 8 * fq;
#pragma unroll
        for (int ai = 0; ai < 2; ++ai) {
            u32x4 gw[4][2], tw[4][2];
            if (MODE != 2) {
#pragma unroll
                for (int m = 0; m < 4; ++m)
#pragma unroll
                    for (int bj = 0; bj < 2; ++bj) { const size_t off = (size_t)(row0 + ai * 128 + m * 16) * 1024 + col0 + bj * 128;
                        gw[m][bj] = __builtin_nontemporal_load((const u32x4*)(G + off)); if (MODE == 1) tw[m][bj] = __builtin_nontemporal_load((const u32x4*)(T1 + off)); }
            }
#pragma unroll
            for (int m = 0; m < 4; ++m) {
                const size_t r = (size_t)(row0 + ai * 128 + m * 16);
#pragma unroll
                for (int bj = 0; bj < 2; ++bj) {
                    const size_t off = r * 1024 + col0 + bj * 128;
                    f32x4 v0 = acc[ai][bj][m][0], v1 = acc[ai][bj][m][1];
                    if (MODE != 2) {
                        const u32x4 g = gw[m][bj];
                        v0 = v0 * (f32x4){bflo(g.x), bfhi(g.x), bflo(g.y), bfhi(g.y)};
                        v1 = v1 * (f32x4){bflo(g.z), bfhi(g.z), bflo(g.w), bfhi(g.w)};
                    }
                    if (MODE == 1) {
                        const u32x4 t = tw[m][bj];
                        v0 = v0 + (f32x4){bflo(t.x), bfhi(t.x), bflo(t.y), bfhi(t.y)};
                        v1 = v1 + (f32x4){bflo(t.z), bfhi(t.z), bflo(t.w), bfhi(t.w)};
                    }
                    store8(O + off, v0, v1);
                }
            }
            asm volatile("" ::: "memory");
        }
    }
};
struct EpiSwiglu {
    bf16_t* U;
    __device__ __forceinline__ void operator()(const Acc& acc, const Unit& u, int wr, int wc, int fr, int fq) const {
        const int row0 = u.pm * 256 + wr * 64 + fr, col0 = u.pn * 128 + wc * 32 + 8 * fq;
#pragma unroll
        for (int ai = 0; ai < 2; ++ai)
#pragma unroll
            for (int m = 0; m < 4; ++m) {
                const size_t r = (size_t)(row0 + ai * 128 + m * 16);
                f32x4 g0 = acc[ai][0][m][0], g1 = acc[ai][0][m][1];
                const f32x4 u0 = acc[ai][1][m][0], u1 = acc[ai][1][m][1];
#pragma unroll
                for (int e = 0; e < 4; ++e) { g0[e] = g0[e] * __builtin_amdgcn_rcpf(1.f + __builtin_amdgcn_exp2f(g0[e] * -1.4426950408889634f)); g1[e] = g1[e] * __builtin_amdgcn_rcpf(1.f + __builtin_amdgcn_exp2f(g1[e] * -1.4426950408889634f)); }
                store8(U + r * DFF + col0, g0 * u0, g1 * u1);
            }
    }
};

struct Args {
    const float* x; const int* pos; const float* ln_mix_pre; const float* w_in;
    const float *lq1, *lk1, *lq2, *lk2; const float* da_subln; const float* q_a_norm; const float* w_uq; const float* kv_a_norm; const float* w_ukv;
    const float *w_pa, *w_pb, *w_o; const float *ln_mix_post, *ln_ffn_pre; const float *w_g, *w_u, *w_d; const float* ln_ffn_post;
    float* out; unsigned char* ws;
    double invf[32];
    int ph_lo, ph_hi;
};

__device__ __forceinline__ void transpose_item(const float* src, int ldsrc, const float* gain, bf16_t* dst, int K, int k0, int n0, LAS float* scr, int lane) {
    if (src) {
#pragma unroll
        for (int i = 0; i < 32; ++i) { const int kk = 2 * i + (lane >> 5); float v = src[(size_t)(k0 + kk) * ldsrc + (lane & 31)]; if (gain) v *= gain[k0 + kk]; scr[kk * 33 + (lane & 31)] = v; }
    } else {
#pragma unroll 8
        for (int i = 0; i < 32; ++i) { const int kk = 2 * i + (lane >> 5); scr[kk * 33 + (lane & 31)] = 0.f; }
    }
    asm volatile("s_waitcnt lgkmcnt(0)" ::: "memory");
    const int c = lane & 7;
#pragma unroll
    for (int j = 0; j < 4; ++j) { const int n = (lane >> 3) + 8 * j; const LAS float* s = scr + (8 * c) * 33 + n;
        u32x4 o; o.x = cvtpk(s[0 * 33], s[1 * 33]); o.y = cvtpk(s[2 * 33], s[3 * 33]); o.z = cvtpk(s[4 * 33], s[5 * 33]); o.w = cvtpk(s[6 * 33], s[7 * 33]);
        *(u32x4*)(dst + (size_t)(n0 + n) * K + k0 + 8 * c) = o; }
    asm volatile("s_waitcnt lgkmcnt(0)" ::: "memory");
}

__device__ __forceinline__ void phase0(const Args& a, LAS unsigned char* lds, int vcu, int G) {
    const int tid = threadIdx.x, lane = tid & 63, wave = __builtin_amdgcn_readfirstlane(tid >> 6);
    LAS float* scr = (LAS float*)(lds + wave * 16384);
    const int gw = vcu * 8 + wave, NGW = G * 8;
    unsigned char* ws = a.ws;
    constexpr int I_W1 = 16 * (N1 / 32), I_WV = 16 * 32, I_UQ = 6 * 48, I_UK = 4 * 32, I_UV = 4 * 32, I_SQ = 16 * 32, I_GU = 16 * 176, I_D = 44 * 32;
    constexpr int NITEMS = I_W1 + I_WV + I_UQ + I_UK + I_UV + 3 * I_SQ + I_GU + I_D;
    for (int it = gw; it < NITEMS; it += NGW) {
        int r = it;
        if (r < I_W1) {
            const int nb = r % (N1 / 32), kb = r / (N1 / 32), n0 = nb * 32; int sc;
            if (n0 < 2048) { const int base = n0 < 1024 ? 0 : 1024, q = n0 & 1023, t = q >> 8, j = q & 255, bj = j >> 7, p = j & 127, sh = p >> 5; sc = base + 256 * t + 64 * sh + 32 * bj; }
            else if (n0 < 3072) sc = 3776 + (n0 - 2048);
            else if (n0 < 4096) sc = 4800 + (n0 - 3072);
            else if (n0 < 4480) sc = 3072 + (n0 - 4096);
            else if (n0 < 4736) sc = 3456 + (n0 - 4480);
            else if (n0 < 4800) sc = 3712 + (n0 - 4736);
            else sc = -1;
            transpose_item(sc >= 0 ? a.w_in + sc : nullptr, IN_COLS, nullptr, (bf16_t*)(ws + WS_W1T), 1024, kb * 64, n0, scr, lane); continue; }
        r -= I_W1;
        if (r < I_WV) { const int nb = r % 32, kb = r / 32; transpose_item(a.w_in + 2048 + nb * 32, IN_COLS, nullptr, (bf16_t*)(ws + WS_WVT), 1024, kb * 64, nb * 32, scr, lane); continue; }
        r -= I_WV;
        if (r < I_UQ) { const int nb = r % 48, kb = r / 48, n0 = nb * 32; int sc;
            if (n0 < 1024) sc = (n0 >> 7) * 192 + (n0 & 127);
            else { const int q = n0 - 1024, tt = q >> 8, j = q & 255, bj = j >> 7, p = j & 127, hh = p >> 5; sc = (4 * tt + hh) * 192 + 128 + 32 * bj; }
            transpose_item(a.w_uq + sc, 1536, a.q_a_norm, (bf16_t*)(ws + WS_WUQT), 384, kb * 64, n0, scr, lane); continue; }
        r -= I_UQ;
        if (r < I_UK) { const int nb = r % 32, kb = r / 32, n0 = nb * 32; transpose_item(a.w_ukv + (n0 >> 7) * 256 + (n0 & 127), 2048, a.kv_a_norm, (bf16_t*)(ws + WS_WUKT), 256, kb * 64, n0, scr, lane); continue; }
        r -= I_UK;
        if (r < I_UV) { const int nb = r % 32, kb = r / 32, n0 = nb * 32; transpose_item(a.w_ukv + (n0 >> 7) * 256 + 128 + (n0 & 127), 2048, a.kv_a_norm, (bf16_t*)(ws + WS_WUVT), 256, kb * 64, n0, scr, lane); continue; }
        r -= I_UV;
        if (r < 3 * I_SQ) { const int w = r / I_SQ, q = r % I_SQ, nb = q % 32, kb = q / 32;
            const float* src = w == 0 ? a.w_pa : (w == 1 ? a.w_pb : a.w_o); bf16_t* dst = (bf16_t*)(ws + (w == 0 ? WS_WPAT : (w == 1 ? WS_WPBT : WS_WOT)));
            transpose_item(src + nb * 32, 1024, nullptr, dst, 1024, kb * 64, nb * 32, scr, lane); continue; }
        r -= 3 * I_SQ;
        if (r < I_GU) { const int nb = r % 176, kb = r / 176, n0 = nb * 32, t = n0 >> 8, j = n0 & 255, bj = j >> 7, p = j & 127;
            transpose_item((bj ? a.w_u : a.w_g) + 128 * t + p, DFF, nullptr, (bf16_t*)(ws + WS_WGUT), 1024, kb * 64, n0, scr, lane); continue; }
        r -= I_GU;
        { const int nb = r % 32, kb = r / 32; transpose_item(a.w_d + nb * 32, 1024, nullptr, (bf16_t*)(ws + WS_WDT), DFF, kb * 64, nb * 32, scr, lane); }
    }
    {
        float* tcos = (float*)(ws + WS_TCOS); float* tsin = (float*)(ws + WS_TSIN);
        for (int e = vcu * NTHR + tid; e < T * 32; e += G * NTHR) {
            const int t = e >> 5, i = e & 31;
            const double ang = (double)a.pos[t] * a.invf[i];
            const double q = rint(ang * 0.63661977236758134308);
            double rr = fma(-q, 1.57079632679489655800e+00, ang); rr = fma(-q, 6.12323399573676603587e-17, rr);
            const double r2 = rr * rr;
            double sp = 1.0 / 6227020800.0; sp = fma(sp, r2, -1.0 / 39916800.0); sp = fma(sp, r2, 1.0 / 362880.0); sp = fma(sp, r2, -1.0 / 5040.0); sp = fma(sp, r2, 1.0 / 120.0); sp = fma(sp, r2, -1.0 / 6.0);
            const double sn = fma(rr * r2, sp, rr);
            double cp = -1.0 / 87178291200.0; cp = fma(cp, r2, 1.0 / 479001600.0); cp = fma(cp, r2, -1.0 / 3628800.0); cp = fma(cp, r2, 1.0 / 40320.0); cp = fma(cp, r2, -1.0 / 720.0); cp = fma(cp, r2, 1.0 / 24.0); cp = fma(cp, r2, -0.5);
            const double cs = fma(r2, cp, 1.0);
            const int qi = ((int)q) & 3;
            const double s_out = (qi == 0) ? sn : (qi == 1) ? cs : (qi == 2) ? -sn : -cs;
            const double c_out = (qi == 0) ? cs : (qi == 1) ? -sn : (qi == 2) ? -cs : sn;
            tcos[e] = (float)c_out; tsin[e] = (float)s_out;
        }
    }
    if (vcu == 0 && tid < 64) {
        const float d1 = wave_sum(a.lq1[lane] * a.lk1[lane]), d2 = wave_sum(a.lq2[lane] * a.lk2[lane]);
        if (lane == 0) ((float*)(ws + WS_CTL))[0] = expf(d1) - expf(d2) + LAMBDA_INIT;
    }
    {
        bf16_t* H = (bf16_t*)(ws + WS_H);
        for (int m0 = gw; m0 < T; m0 += RP * NGW) {
            f32x4 v[RP][4]; float sq[RP];
#pragma unroll
            for (int r = 0; r < RP; ++r) { const int m = m0 + r * NGW < T ? m0 + r * NGW : m0; const f32x4* xr = (const f32x4*)(a.x + (size_t)m * DM) + lane;
#pragma unroll
                for (int j = 0; j < 4; ++j) v[r][j] = __builtin_nontemporal_load(xr + 64 * j); }
#pragma unroll
            for (int r = 0; r < RP; ++r) { float s = 0.f;
#pragma unroll
                for (int j = 0; j < 4; ++j) s += (v[r][j].x * v[r][j].x + v[r][j].y * v[r][j].y) + (v[r][j].z * v[r][j].z + v[r][j].w * v[r][j].w);
                sq[r] = s; }
#pragma unroll
            for (int r = 0; r < RP; ++r) { const int m = m0 + r * NGW; if (m >= T) break;
                const float rstd = 1.f / sqrtf(wave_sum(sq[r]) * (1.f / DM) + RMS_EPS);
                u32x2* o8 = (u32x2*)(H + (size_t)m * DM) + lane;
#pragma unroll
                for (int j = 0; j < 4; ++j) { const f32x4 g = ((const f32x4*)a.ln_mix_pre)[lane + 64 * j]; const f32x4 y = v[r][j] * rstd * g; u32x2 w; w.x = cvtpk(y.x, y.y); w.y = cvtpk(y.z, y.w); o8[64 * j] = w; } }
        }
    }
}

__device__ __forceinline__ void phase_mla_prep(const Args& a, int vcu, int G) {
    const int tid = threadIdx.x, lane = tid & 63, wave = __builtin_amdgcn_readfirstlane(tid >> 6);
    const int gw = vcu * 8 + wave, NGW = G * 8;
    unsigned char* ws = a.ws;
    const bf16_t* cq = (const bf16_t*)(ws + WS_CQ); const bf16_t* ckv = (const bf16_t*)(ws + WS_CKV); bf16_t* kr = (bf16_t*)(ws + WS_KR);
    float* rq = (float*)(ws + WS_RSTDQ); float* rkv = (float*)(ws + WS_RSTDKV);
    const float* tcos = (const float*)(ws + WS_TCOS); const float* tsin = (const float*)(ws + WS_TSIN);
    for (int m0 = gw * 4; m0 < T; m0 += NGW * 4) {
        unsigned wq[4][3], wk[4][2]; float x1[4], x2[4], cs[4], sn[4];
#pragma unroll
        for (int r = 0; r < 4; ++r) {
            const size_t m = (size_t)(m0 + r);
            const unsigned* p = (const unsigned*)(cq + m * 384); const unsigned* p2 = (const unsigned*)(ckv + m * 256);
#pragma unroll
            for (int j = 0; j < 3; ++j) wq[r][j] = p[lane + 64 * j];
#pragma unroll
            for (int j = 0; j < 2; ++j) wk[r][j] = p2[lane + 64 * j];
            x1[r] = bf2f(kr[m * 64 + (lane & 31)]); x2[r] = bf2f(kr[m * 64 + 32 + (lane & 31)]);
            cs[r] = tcos[m * 32 + (lane & 31)]; sn[r] = tsin[m * 32 + (lane & 31)];
        }
#pragma unroll
        for (int r = 0; r < 4; ++r) {
            const size_t m = (size_t)(m0 + r);
            float s = 0.f, s2 = 0.f;
#pragma unroll
            for (int j = 0; j < 3; ++j) { const float lo = bflo(wq[r][j]), hi = bfhi(wq[r][j]); s += lo * lo + hi * hi; }
#pragma unroll
            for (int j = 0; j < 2; ++j) { const float lo = bflo(wk[r][j]), hi = bfhi(wk[r][j]); s2 += lo * lo + hi * hi; }
            s = wave_sum(s); s2 = wave_sum(s2);
            if (lane == 0) { rq[m] = 1.f / sqrtf(s * (1.f / 384.f) + RMS_EPS); rkv[m] = 1.f / sqrtf(s2 * (1.f / 256.f) + RMS_EPS); }
            if (lane < 32) {
                const float y1 = x1[r] * cs[r] - x2[r] * sn[r], y2 = x2[r] * cs[r] + x1[r] * sn[r];
                kr[m * 64 + lane] = (bf16_t)(cvtpk(y1, 0.f) & 0xffffu); kr[m * 64 + 32 + lane] = (bf16_t)(cvtpk(y2, 0.f) & 0xffffu);
            }
        }
    }
}

__device__ __forceinline__ void phase_post_mix(const Args& a, int vcu, int G) {
    const int tid = threadIdx.x, lane = tid & 63, wave = __builtin_amdgcn_readfirstlane(tid >> 6);
    const int gw = vcu * 8 + wave, NGW = G * 8;
    bf16_t* H2 = (bf16_t*)(a.ws + WS_H2);
    for (int m0 = gw; m0 < T; m0 += RP * NGW) {
        f32x4 v[RP][4], xv[RP][4]; float sq[RP];
#pragma unroll
        for (int r = 0; r < RP; ++r) { const int m = m0 + r * NGW < T ? m0 + r * NGW : m0;
            const u32x2* t2r = (const u32x2*)((const bf16_t*)(a.ws + WS_T2) + (size_t)m * DM) + lane;
            const f32x4* xr = (const f32x4*)(a.x + (size_t)m * DM) + lane;
#pragma unroll
            for (int j = 0; j < 4; ++j) { const u32x2 w = t2r[64 * j]; v[r][j] = (f32x4){bflo(w.x), bfhi(w.x), bflo(w.y), bfhi(w.y)}; xv[r][j] = __builtin_nontemporal_load(xr + 64 * j); } }
#pragma unroll
        for (int r = 0; r < RP; ++r) { float s = 0.f;
#pragma unroll
            for (int j = 0; j < 4; ++j) s += (v[r][j].x * v[r][j].x + v[r][j].y * v[r][j].y) + (v[r][j].z * v[r][j].z + v[r][j].w * v[r][j].w);
            sq[r] = wave_sum(s); }
#pragma unroll
        for (int r = 0; r < RP; ++r) { const int m = m0 + r * NGW; if (m >= T) break;
            const float rstd = 1.f / sqrtf(sq[r] * (1.f / DM) + RMS_EPS);
            if (lane == 0) ((float*)(a.ws + WS_RSTDQ))[m] = rstd;
            float s2 = 0.f;
#pragma unroll
            for (int j = 0; j < 4; ++j) { const f32x4 g = ((const f32x4*)a.ln_mix_post)[lane + 64 * j]; v[r][j] = xv[r][j] + v[r][j] * rstd * g;
                s2 += (v[r][j].x * v[r][j].x + v[r][j].y * v[r][j].y) + (v[r][j].z * v[r][j].z + v[r][j].w * v[r][j].w); }
            const float rstd2 = 1.f / sqrtf(wave_sum(s2) * (1.f / DM) + RMS_EPS);
            u32x2* o8 = (u32x2*)(H2 + (size_t)m * DM) + lane;
#pragma unroll
            for (int j = 0; j < 4; ++j) { const f32x4 g = ((const f32x4*)a.ln_ffn_pre)[lane + 64 * j]; const f32x4 y = v[r][j] * rstd2 * g; u32x2 w; w.x = cvtpk(y.x, y.y); w.y = cvtpk(y.z, y.w); o8[64 * j] = w; } }
    }
}
__device__ __forceinline__ void phase_final(const Args& a, int vcu, int G) {
    const int tid = threadIdx.x, lane = tid & 63, wave = __builtin_amdgcn_readfirstlane(tid >> 6);
    const int gw = vcu * 8 + wave, NGW = G * 8;
    const bf16_t* F = (const bf16_t*)(a.ws + WS_F); const bf16_t* T2 = (const bf16_t*)(a.ws + WS_T2); const float* R1 = (const float*)(a.ws + WS_RSTDQ);
    for (int m0 = gw; m0 < T; m0 += RP * NGW) {
        f32x4 v[RP][4], xv[RP][4]; float sq[RP];
#pragma unroll
        for (int r = 0; r < RP; ++r) { const int m = m0 + r * NGW < T ? m0 + r * NGW : m0;
            const u32x2* fr = (const u32x2*)(F + (size_t)m * DM) + lane; const u32x2* tr = (const u32x2*)(T2 + (size_t)m * DM) + lane;
            const f32x4* xr = (const f32x4*)(a.x + (size_t)m * DM) + lane; const float r1 = R1[m];
#pragma unroll
            for (int j = 0; j < 4; ++j) { const u32x2 w = __builtin_nontemporal_load(fr + 64 * j); v[r][j] = (f32x4){bflo(w.x), bfhi(w.x), bflo(w.y), bfhi(w.y)};
                const u32x2 w2 = __builtin_nontemporal_load(tr + 64 * j); const f32x4 t2v = (f32x4){bflo(w2.x), bfhi(w2.x), bflo(w2.y), bfhi(w2.y)};
                const f32x4 g1 = ((const f32x4*)a.ln_mix_post)[lane + 64 * j]; xv[r][j] = __builtin_nontemporal_load(xr + 64 * j) + t2v * r1 * g1; } }
#pragma unroll
        for (int r = 0; r < RP; ++r) { float s = 0.f;
#pragma unroll
            for (int j = 0; j < 4; ++j) s += (v[r][j].x * v[r][j].x + v[r][j].y * v[r][j].y) + (v[r][j].z * v[r][j].z + v[r][j].w * v[r][j].w);
            sq[r] = wave_sum(s); }
#pragma unroll
        for (int r = 0; r < RP; ++r) { const int m = m0 + r * NGW; if (m >= T) break;
            f32x4* orow = (f32x4*)(a.out + (size_t)m * DM) + lane;
            const float rstd = 1.f / sqrtf(sq[r] * (1.f / DM) + RMS_EPS);
#pragma unroll
            for (int j = 0; j < 4; ++j) { const f32x4 g = ((const f32x4*)a.ln_ffn_post)[lane + 64 * j]; __builtin_nontemporal_store(xv[r][j] + v[r][j] * rstd * g, orow + 64 * j); } }
    }
}

#define MFMA32(a, b, c) __builtin_amdgcn_mfma_f32_32x32x16_bf16((a), (b), (c), 0, 0, 0)
template <int MODE>
__device__ __forceinline__ void attn_unit(LAS unsigned char* lds, const Args& a, int b, int h, int qb) {
    constexpr int KB_ = 16384, RB_ = MODE == 1 ? 8192 : 0, VB_ = 16384, STAGE = KB_ + RB_ + VB_;
    constexpr int NK = MODE == 0 ? 4 : 12;
    constexpr int NI = MODE == 0 ? 4 : 5;
    constexpr int QROWS = MODE == 0 ? 128 : 256;
    int tid = threadIdx.x; asm volatile("" : "+v"(tid));
    const int lane = tid & 63, hi = lane >> 5, ql = lane & 31;
    const int wid = __builtin_amdgcn_readfirstlane(tid >> 6);
    const int grp = MODE == 0 ? (wid & 3) : wid, which = MODE == 0 ? (wid >> 2) : 0;
    const int q0 = qb * QROWS;
    const int cw = (q0 + grp * 32) >> 6;
    const int nt = (q0 + QROWS) >> 6;
    const size_t bS = (size_t)b * SEQ;
    const size_t tq = bS + q0 + grp * 32 + ql;
    unsigned char* ws = a.ws;
    const bf16_t* Ksrc = MODE == 0 ? (const bf16_t*)(ws + WS_KA) : (const bf16_t*)(a.out);
    const bf16_t* Vsrc = MODE == 0 ? (const bf16_t*)(ws + WS_VAT) : (const bf16_t*)((unsigned char*)a.out + OUT_VBT);
    const char* kbase = (const char*)(Ksrc + bS * 1024 + h * 128);
    const char* vbase = (const char*)(Vsrc + (size_t)(h * 128) * T + bS);
    const char* rbase = (const char*)((const bf16_t*)(ws + WS_KR) + bS * 64);
    unsigned kso[2], vso[2], rso;
#pragma unroll
    for (int j = 0; j < 2; ++j) {
        { const int row = 4 * (wid * 2 + j) + (lane >> 4), c = (lane & 15) ^ (row & 15); kso[j] = (unsigned)(row * 2048 + c * 16); }
        { const int row = 8 * (wid * 2 + j) + (lane >> 3), c = (lane & 7) ^ ((row >> 1) & 7); vso[j] = (unsigned)(row * (T * 2) + c * 16); }
    }
    { const int row = 8 * wid + (lane >> 3), c = (lane & 7) ^ ((row >> 1) & 7); rso = (unsigned)(row * 128 + c * 16); }
#define ATT_DMA(kt, buf) do { const char* kb_ = kbase + (size_t)(kt) * (64 * 1024 * 2); const char* vb_ = vbase + (size_t)(kt) * 128; LAS unsigned char* sb_ = lds + (buf) * STAGE; \
        _Pragma("unroll") for (int j = 0; j < 2; ++j) { \
            __builtin_amdgcn_global_load_lds((const unsigned*)(kb_ + kso[j]), (LAS unsigned*)(sb_ + (wid * 2 + j) * 1024), 16, 0, 0); \
            __builtin_amdgcn_global_load_lds((const unsigned*)(vb_ + vso[j]), (LAS unsigned*)(sb_ + KB_ + RB_ + (wid * 2 + j) * 1024), 16, 0, 0); } \
        if (MODE == 1) __builtin_amdgcn_global_load_lds((const unsigned*)(rbase + (size_t)(kt) * (64 * 64 * 2) + rso), (LAS unsigned*)(sb_ + KB_ + wid * 1024), 16, 0, 0); } while (0)
    asm volatile("s_waitcnt vmcnt(0)" ::: "memory"); __builtin_amdgcn_s_barrier();
    ATT_DMA(0, 0); ATT_DMA(1, 1);
    bf16x8 qf[NK];
    if (MODE == 0) {
        const bf16_t* Q = (const bf16_t*)(ws + WS_QA) + tq * 1024 + h * 128 + which * 64 + 8 * hi;
#pragma unroll
        for (int ks = 0; ks < 4; ++ks) qf[ks] = *(const bf16x8*)(Q + 16 * ks);
    } else {
        const bf16_t* Q = (const bf16_t*)(ws + WS_QB) + tq * 1536 + 8 * hi;
#pragma unroll
        for (int ks = 0; ks < 8; ++ks) qf[ks] = *(const bf16x8*)(Q + h * 128 + 16 * ks);
#pragma unroll
        for (int ks = 8; ks < 12; ++ks) qf[ks] = *(const bf16x8*)(Q + 1024 + h * 64 + 16 * (ks - 8));
    }
    const int g_ = ql >> 3, hb_ = (ql >> 2) & 1, j_ = ql & 3;
    const int pim = 16 * (g_ >> 1) + 8 * hb_ + 4 * (g_ & 1) + j_;
    unsigned kl[MODE == 0 ? 4 : 8], rl[4], vl[4];
#pragma unroll
    for (int ks = 0; ks < (MODE == 0 ? 4 : 8); ++ks) kl[ks] = (unsigned)(pim * 256 + ((((MODE == 0 ? which * 8 : 0) + 2 * ks + hi) ^ (pim & 15)) * 16));
#pragma unroll
    for (int ks = 0; ks < 4; ++ks) { rl[ks] = (unsigned)(KB_ + pim * 128 + (((2 * ks + hi) ^ ((pim >> 1) & 7)) * 16)); vl[ks] = (unsigned)(KB_ + RB_ + ql * 128 + (((2 * ks + hi) ^ ((ql >> 1) & 7)) * 16)); }
    f32x16 o[4];
#pragma unroll
    for (int d = 0; d < 4; ++d)
#pragma unroll
        for (int i = 0; i < 16; ++i) o[d][i] = 0.f;
    float mrun = 0.f, lrun = 0.f;
    f32x16 negm;
#pragma unroll
    for (int i = 0; i < 16; ++i) negm[i] = 0.f;
    asm volatile("s_waitcnt vmcnt(0)" ::: "memory"); __builtin_amdgcn_s_barrier();
    int bcur = 0, bnext2 = 2;
    for (int kt = 0; kt < nt; ++kt) {
        if (kt + 2 < nt) ATT_DMA(kt + 2, bnext2);
        if (kt <= cw) {
            const LAS unsigned char* base = lds + bcur * STAGE;
            f32x16 s0, s1;
            bf16x8 ka[2][2];
#define ATT_LDK(bf, ks) do { if ((ks) < (MODE == 0 ? 4 : 8)) { ka[bf][0] = *(const LAS bf16x8*)(base + kl[(ks) & 7]); ka[bf][1] = *(const LAS bf16x8*)(base + kl[(ks) & 7] + 32 * 256); } \
        else { ka[bf][0] = *(const LAS bf16x8*)(base + rl[(ks) & 3]); ka[bf][1] = *(const LAS bf16x8*)(base + rl[(ks) & 3] + 32 * 128); } } while (0)
            ATT_LDK(0, 0);
#pragma unroll
            for (int ks = 0; ks < NK; ++ks) {
                if (ks + 1 < NK) ATT_LDK((ks + 1) & 1, ks + 1);
                __builtin_amdgcn_sched_barrier(0);

                if (ks == 0) { s0 = MFMA32(ka[0][0], qf[0], negm); s1 = MFMA32(ka[0][1], qf[0], negm); }
                else { s0 = MFMA32(ka[ks & 1][0], qf[ks], s0); s1 = MFMA32(ka[ks & 1][1], qf[ks], s1); }

                __builtin_amdgcn_sched_barrier(0);
            }
#undef ATT_LDK
            bf16x8 va[2][4];
#define ATT_LDVK(bf, kk) do { _Pragma("unroll") for (int d = 0; d < 4; ++d) va[bf][d] = *(const LAS bf16x8*)(base + vl[kk] + d * 32 * 128); } while (0)
            ATT_LDVK(0, 0);
            float mx0 = fmaxf(s0[0], s0[1]), mx1 = fmaxf(s1[0], s1[1]);
#pragma unroll
            for (int i = 2; i < 16; i += 2) { mx0 = fmaxf(fmaxf(mx0, s0[i]), s0[i + 1]); mx1 = fmaxf(fmaxf(mx1, s1[i]), s1[i + 1]); }
            const float mxs = xhalf_max(fmaxf(mx0, mx1));
            if (kt == 0) {
                mrun = mxs; s0 = s0 - mxs; s1 = s1 - mxs;
#pragma unroll
                for (int i = 0; i < 16; ++i) negm[i] = -mrun;
            } else if (__builtin_amdgcn_ballot_w64(mxs > 8.0f) != 0ull) {
                const float delta = fmaxf(mxs, 0.f);
                const float alpha = __builtin_amdgcn_exp2f(-delta);
                mrun += delta; lrun *= alpha; s0 = s0 - delta; s1 = s1 - delta;
#pragma unroll
                for (int d = 0; d < 4; ++d) o[d] = o[d] * alpha;
#pragma unroll
                for (int i = 0; i < 16; ++i) negm[i] = -mrun;
            }
            __builtin_amdgcn_sched_barrier(0);
            bf16x8 p[4]; float psum;
#define ATT_SLICE(g, S, off) do { _Pragma("unroll") for (int i = 0; i < 8; ++i) S[(off) + i] = __builtin_amdgcn_exp2f(S[(off) + i]); \
        u32x4 w_; w_.x = cvtpk(S[(off)], S[(off) + 1]); w_.y = cvtpk(S[(off) + 2], S[(off) + 3]); w_.z = cvtpk(S[(off) + 4], S[(off) + 5]); w_.w = cvtpk(S[(off) + 6], S[(off) + 7]); p[g] = __builtin_bit_cast(bf16x8, w_); \
        const float t_ = ((S[(off)] + S[(off) + 1]) + (S[(off) + 2] + S[(off) + 3])) + ((S[(off) + 4] + S[(off) + 5]) + (S[(off) + 6] + S[(off) + 7])); if ((g) == 0) psum = t_; else psum += t_; } while (0)
            ATT_SLICE(0, s0, 0);
#pragma unroll
            for (int g = 0; g < 4; ++g) {
                if (g + 1 < 4) ATT_LDVK((g + 1) & 1, g + 1);
#pragma unroll
                for (int d = 0; d < 4; ++d) o[d] = MFMA32(va[g & 1][d], p[g], o[d]);
                if (g == 0) ATT_SLICE(1, s0, 8);
                if (g == 1) ATT_SLICE(2, s1, 0);
                if (g == 2) ATT_SLICE(3, s1, 8);
#pragma unroll
                for (int i = 0; i < 4; ++i) { __builtin_amdgcn_sched_group_barrier(0x008, 1, 0); __builtin_amdgcn_sched_group_barrier(0x100, 1, 0); __builtin_amdgcn_sched_group_barrier(0x002, 5, 0); }
            }
            __builtin_amdgcn_sched_barrier(0);
            lrun += psum;
#undef ATT_SLICE
#undef ATT_LDVK
        }
        if (kt + 2 < nt) { if (MODE == 0) asm volatile("s_waitcnt vmcnt(4)" ::: "memory"); else asm volatile("s_waitcnt vmcnt(5)" ::: "memory"); }
        else asm volatile("s_waitcnt vmcnt(0)" ::: "memory");
        __builtin_amdgcn_s_barrier();
        bcur = (bcur == 2) ? 0 : bcur + 1; bnext2 = (bnext2 == 2) ? 0 : bnext2 + 1;
    }
#undef ATT_DMA
    lrun = xhalf_sum(lrun);
    const float inv = 1.f / lrun;
    if (MODE == 1) {
        bf16_t* O = (bf16_t*)(ws + WS_QB) + tq * 1536 + h * 128 + 4 * hi;
#pragma unroll
        for (int d = 0; d < 4; ++d)
#pragma unroll
            for (int g = 0; g < 4; ++g) {
                u32x2 w; w.x = cvtpk(o[d][4 * g] * inv, o[d][4 * g + 1] * inv); w.y = cvtpk(o[d][4 * g + 2] * inv, o[d][4 * g + 3] * inv);
                *(u32x2*)(O + 32 * d + 8 * g) = w;
            }
    } else {
        LAS float* X = (LAS float*)lds;
        const float lam = ((const float*)(ws + WS_CTL))[0];
        if (which == 1) {
#pragma unroll
            for (int d = 0; d < 4; ++d)
#pragma unroll
                for (int i = 0; i < 16; ++i) X[(d * 16 + i) * 256 + grp * 64 + lane] = o[d][i] * inv;
        }
        __syncthreads();
        if (which == 0) {
            float ssq = 0.f;
#pragma unroll
            for (int d = 0; d < 4; ++d)
#pragma unroll
                for (int i = 0; i < 16; ++i) { const float v = o[d][i] * inv - lam * X[(d * 16 + i) * 256 + grp * 64 + lane]; o[d][i] = v; ssq += v * v; }
            ssq = xhalf_sum(ssq);
            const float rstd = (1.f / sqrtf(ssq * (1.f / 128.f) + RMS_EPS)) * (1.f - LAMBDA_INIT);
            bf16_t* O = (bf16_t*)(ws + WS_QA) + tq * 1024 + h * 128 + 4 * hi;
#pragma unroll
            for (int d = 0; d < 4; ++d)
#pragma unroll
                for (int g = 0; g < 4; ++g) {
                    const f32x4 gn = *(const f32x4*)(a.da_subln + 32 * d + 8 * g + 4 * hi);
                    u32x2 w; w.x = cvtpk(o[d][4 * g] * rstd * gn.x, o[d][4 * g + 1] * rstd * gn.y); w.y = cvtpk(o[d][4 * g + 2] * rstd * gn.z, o[d][4 * g + 3] * rstd * gn.w);
                    *(u32x2*)(O + 32 * d + 8 * g) = w;
                }
        }
        __syncthreads();
    }
}

__device__ __forceinline__ void phase_attn(const Args& a, LAS unsigned char* lds, int vcu, int G) {
#pragma unroll 1
    for (int p2 = 2 * vcu; p2 < 2048; p2 += 2 * G) {
#pragma unroll 1
        for (int hf = 0; hf < 2; ++hf) {
            const int p = p2 >> 1, bh = p >> 5, pr = p & 31;
            attn_unit<0>(lds, a, bh >> 3, bh & 7, hf ? pr : 63 - pr);
        }
    }
    if (G == 256) {
        const int x = vcu >> 5, j = vcu & 31;
#pragma unroll 1
        for (int r = 0; r < 4; ++r) {
            const int bh = 4 * x + r;
            const int qb = (r & 1) ? (j < 16 ? j : 47 - j) : (j < 16 ? 31 - j : j - 16);
            attn_unit<1>(lds, a, bh >> 3, bh & 7, qb);
        }
    } else {
#pragma unroll 1
        for (int p2 = 2 * vcu; p2 < 1024; p2 += 2 * G) {
#pragma unroll 1
            for (int hf = 0; hf < 2; ++hf) {
                const int p = p2 >> 1, bh = p >> 4, pr = p & 15;
                attn_unit<1>(lds, a, bh >> 3, bh & 7, hf ? pr : 31 - pr);
            }
        }
    }
}

#define XB_TMO      128
#define XB_XCNT(j)  (256  + 64 * (j))
#define XB_XSUB(j)  (1280 + 64 * (j))
#define XB_XGEN(j)  (2304 + 64 * (j))
#define XB_TOP      3328
#define XB_TOPGEN   3392
#define XCD_BAR_WORDS 3456
#define XB_SPIN_CAP (1u << 22)
__device__ __forceinline__ unsigned xb_ld(unsigned* p)              { return __hip_atomic_load(p, __ATOMIC_RELAXED, __HIP_MEMORY_SCOPE_AGENT); }
__device__ __forceinline__ unsigned xb_add(unsigned* p, unsigned v) { return __hip_atomic_fetch_add(p, v, __ATOMIC_RELAXED, __HIP_MEMORY_SCOPE_AGENT); }
__device__ __forceinline__ unsigned xb_xcc_id() { return (unsigned)__builtin_amdgcn_s_getreg((3 << 11) | 20) & 0xFu; }
#define XB_SPIN(cond, bar) do { unsigned _sp = 0; while (cond) { __builtin_amdgcn_s_sleep(1); \
    if ((++_sp & 255u) == 0u) { if (xb_ld(&(bar)[XB_TMO])) break; if (_sp > XB_SPIN_CAP) { atomicAdd(&(bar)[XB_TMO], 1u); break; } } } } while (0)
struct XcdBarrier { unsigned* bar; unsigned x; volatile LAS unsigned* st; };
__device__ __forceinline__ XcdBarrier xcd_barrier_post(unsigned* bar, volatile LAS unsigned* st) {
    XcdBarrier b; b.bar = bar; b.x = xb_xcc_id(); b.st = st;
    if (threadIdx.x == 0) (void)xb_add(&bar[XB_XCNT(b.x)], 1u);
    return b;
}
__device__ __forceinline__ void xcd_barrier_complete(unsigned* bar, unsigned x, unsigned& nloc, unsigned& nx) {
    const unsigned G = gridDim.x * gridDim.y * gridDim.z;
    unsigned sum, cnt, mine, sp = 0u;
    for (;;) {
        sum = 0u; cnt = 0u; mine = 0u;
#pragma unroll
        for (unsigned j = 0; j < 16; ++j) { const unsigned c = xb_ld(&bar[XB_XCNT(j)]); sum += c; cnt += (c > 0u) ? 1u : 0u; mine = (j == x) ? c : mine; }
        if (sum == G) break;
        __builtin_amdgcn_s_sleep(1);
        if ((++sp & 255u) == 0u) { if (xb_ld(&bar[XB_TMO])) break; if (sp > XB_SPIN_CAP) { atomicAdd(&bar[XB_TMO], 1u); break; } }
    }
    nloc = mine > 0u ? mine : 1u; nx = cnt > 0u ? cnt : 1u;
}
__device__ __forceinline__ void xcd_barrier(const XcdBarrier& b) {
    asm volatile("s_waitcnt vmcnt(0)" ::: "memory");
    __syncthreads();
    if (threadIdx.x == 0) {
        unsigned* bar = b.bar;
        __builtin_amdgcn_s_waitcnt(0);
        unsigned nloc = b.st[0], nx = b.st[1];
        if (nloc == 0u) { xcd_barrier_complete(bar, b.x, nloc, nx); b.st[0] = nloc; b.st[1] = nx; }
        const unsigned old = xb_add(&bar[XB_XSUB(b.x)], 1u);
        const unsigned gen = old / nloc;
        if (old + 1u == (gen + 1u) * nloc) {
            __builtin_amdgcn_fence(__ATOMIC_RELEASE, "agent");
            asm volatile("s_waitcnt vmcnt(0)" ::: "memory");
            const unsigned og = xb_add(&bar[XB_TOP], 1u);
            const unsigned tg = og / nx;
            if (og + 1u == (tg + 1u) * nx) xb_add(&bar[XB_TOPGEN], 1u);
            else XB_SPIN(xb_ld(&bar[XB_TOPGEN]) == tg, bar);
            __builtin_amdgcn_fence(__ATOMIC_ACQUIRE, "agent");
            xb_add(&bar[XB_XGEN(b.x)], 1u);
            asm volatile("s_waitcnt vmcnt(0)" ::: "memory");
        } else {
            XB_SPIN(xb_ld(&bar[XB_XGEN(b.x)]) == gen, bar);
            __builtin_amdgcn_fence(__ATOMIC_ACQUIRE, "agent");
            asm volatile("s_waitcnt vmcnt(0)" ::: "memory");
        }
    }
    __syncthreads();
}

__global__ void __launch_bounds__(NTHR, 2) fwd_kernel(Args a) {
    extern __shared__ __attribute__((aligned(16))) unsigned char lds_raw[];
    LAS unsigned char* lds = (LAS unsigned char*)lds_raw;
    cg::grid_group grid = cg::this_grid();
    const int G = gridDim.x; const int bx = blockIdx.x;
    const int vcu = (G % 8 == 0) ? (bx % 8) * (G / 8) + bx / 8 : bx;
    unsigned char* ws = a.ws;
    const int lo = a.ph_lo, hi = a.ph_hi;
    volatile LAS unsigned* bst = (volatile LAS unsigned*)(lds + LDS_BYTES - 16);
    if (threadIdx.x < 4) bst[threadIdx.x] = 0u;
    __syncthreads();
    const XcdBarrier xbar = xcd_barrier_post((unsigned*)(ws + WS_BAR), bst);
#ifndef PHMASK
#define PHMASK 0xFFF
#endif
#define IN(k) (((PHMASK >> (k)) & 1) && lo <= (k) && (k) < hi)
#define SEAM(k) do { if (IN(k) && IN((k) + 1)) xcd_barrier(xbar); } while (0)
    if (lo < 0) grid.sync();
    bf16_t* Qa = (bf16_t*)(ws + WS_QA); bf16_t* Ka = (bf16_t*)(ws + WS_KA); bf16_t* Ga = (bf16_t*)(ws + WS_GA); bf16_t* Gb = (bf16_t*)(ws + WS_GB);
    bf16_t* VaT = (bf16_t*)(ws + WS_VAT); bf16_t* cq = (bf16_t*)(ws + WS_CQ); bf16_t* ckv = (bf16_t*)(ws + WS_CKV); bf16_t* kr = (bf16_t*)(ws + WS_KR);
    bf16_t* H = (bf16_t*)(ws + WS_H); bf16_t* Qb = (bf16_t*)(ws + WS_QB);
    bf16_t* Kb = (bf16_t*)((unsigned char*)a.out + OUT_KB); bf16_t* VbT = (bf16_t*)((unsigned char*)a.out + OUT_VBT);
    const float* tcos = (const float*)(ws + WS_TCOS); const float* tsin = (const float*)(ws + WS_TSIN);
    const float* rq = (const float*)(ws + WS_RSTDQ); const float* rkv = (const float*)(ws + WS_RSTDKV);
    pg8::StaticOrder S;

    if (IN(0)) { phase0(a, lds, vcu, G); __syncthreads(); }
    SEAM(0);
    if (IN(1)) {
        { pg8::Gemm g{H, (const bf16_t*)(ws + WS_W1T), T, N1, 1024, 1024, 1024}; S.init(T, N1, G, bx);
          EpiG1 E{Qa, Ka, Ga, Gb, cq, ckv, kr, tcos, tsin}; pg8::gemm_phase(lds, g, S, E); }
        { pg8::Gemm g{(const bf16_t*)(ws + WS_WVT), H, 1024, T, 1024, 1024, 1024}; S.init(1024, T, G, bx, G == 256 ? 128 : 0);
          EpiBf16<false, false> E{VaT, T, nullptr, nullptr}; pg8::gemm_phase(lds, g, S, E); }
    }
    SEAM(1);
    if (IN(2)) phase_mla_prep(a, vcu, G);
    SEAM(2);
    if (IN(3)) {
        { pg8::Gemm g{cq, (const bf16_t*)(ws + WS_WUQT), T, 1536, 384, 384, 384}; S.init(T, 1536, G, bx);
          EpiQb E{Qb, rq, tcos, tsin}; pg8::gemm_phase(lds, g, S, E); }
        { pg8::Gemm g{ckv, (const bf16_t*)(ws + WS_WUKT), T, 1024, 256, 256, 256}; S.init(T, 1024, G, bx);
          EpiBf16<true, false> E{Kb, 1024, rkv, nullptr}; pg8::gemm_phase(lds, g, S, E); }
        { pg8::Gemm g{(const bf16_t*)(ws + WS_WUVT), ckv, 1024, T, 256, 256, 256}; S.init(1024, T, G, bx);
          EpiBf16<false, true> E{VbT, T, nullptr, rkv}; pg8::gemm_phase(lds, g, S, E); }
    }
    SEAM(3);
    if (IN(4)) phase_attn(a, lds, vcu, G);
    SEAM(4);
    if (IN(5)) { pg8::Gemm g{Qa, (const bf16_t*)(ws + WS_WPAT), T, 1024, 1024, 1024, 1024}; S.init(T, 1024, G, bx);
        EpiMix<0> E{Ga, nullptr, (bf16_t*)a.out}; pg8::gemm_phase(lds, g, S, E); }
    if (IN(6)) { pg8::Gemm g{Qb, (const bf16_t*)(ws + WS_WPBT), T, 1024, 1024, 1536, 1024}; S.init(T, 1024, G, bx);
        EpiMix<1> E{Gb, (const bf16_t*)a.out, (bf16_t*)(ws + WS_MERGED)}; pg8::gemm_phase(lds, g, S, E); }
    SEAM(6);
    if (IN(7)) { pg8::Gemm g{(const bf16_t*)(ws + WS_MERGED), (const bf16_t*)(ws + WS_WOT), T, 1024, 1024, 1024, 1024}; S.init(T, 1024, G, bx);
        EpiMix<2> E{nullptr, nullptr, (bf16_t*)(ws + WS_T2)}; pg8::gemm_phase(lds, g, S, E); }
    SEAM(7);
    if (IN(8)) phase_post_mix(a, vcu, G);
    SEAM(8);
    if (IN(9)) { pg8::Gemm g{(const bf16_t*)(ws + WS_H2), (const bf16_t*)(ws + WS_WGUT), T, 5632, 1024, 1024, 1024}; S.init(T, 5632, G, bx);
        EpiSwiglu E{(bf16_t*)(ws + WS_U)}; pg8::gemm_phase(lds, g, S, E); }
    SEAM(9);
    if (IN(10)) { pg8::Gemm g{(const bf16_t*)(ws + WS_U), (const bf16_t*)(ws + WS_WDT), T, 1024, DFF, DFF, DFF}; S.init(T, 1024, G, bx);
        EpiMix<2> E{nullptr, nullptr, (bf16_t*)(ws + WS_F)}; pg8::gemm_phase(lds, g, S, E); }
    SEAM(10);
    if (IN(11)) phase_final(a, vcu, G);
#undef IN
#undef SEAM
}

constexpr int N_PHASES = 12;
#ifndef MK_MULTI
#define MK_MULTI 0
#endif

extern "C" void kernel_launch(void* const* d_in, const int* in_sizes, int n_in, void* d_out, int out_size, void* d_ws, size_t ws_size, hipStream_t stream) {
    static int grid = 0;
    if (grid == 0) {
        if (n_in != 22 || in_sizes[0] != T * DM || out_size != T * DM || ws_size < WS_END) { fprintf(stderr, "kernel_launch: unexpected shapes / workspace (%zu)\n", ws_size); grid = -1; return; }
        int dev = 0, cus = 0, per_cu = 0;
        (void)hipGetDevice(&dev);
        (void)hipDeviceGetAttribute(&cus, hipDeviceAttributeMultiprocessorCount, dev);
        (void)hipFuncSetAttribute((const void*)fwd_kernel, hipFuncAttributeMaxDynamicSharedMemorySize, LDS_BYTES);
        (void)hipOccupancyMaxActiveBlocksPerMultiprocessor(&per_cu, (const void*)fwd_kernel, NTHR, LDS_BYTES);
        if (per_cu < 1) per_cu = 1;
        grid = cus * per_cu;
        (void)hipGetLastError();
    }
    if (grid < 0) return;
    (void)hipMemsetAsync((unsigned char*)d_ws + WS_BAR, 0, WS_BAR_BYTES, stream);
    Args a;
    memset(&a, 0, sizeof(a));
    a.x = (const float*)d_in[0]; a.pos = (const int*)d_in[1]; a.ln_mix_pre = (const float*)d_in[2]; a.w_in = (const float*)d_in[3];
    a.lq1 = (const float*)d_in[4]; a.lk1 = (const float*)d_in[5]; a.lq2 = (const float*)d_in[6]; a.lk2 = (const float*)d_in[7];
    a.da_subln = (const float*)d_in[8]; a.q_a_norm = (const float*)d_in[9]; a.w_uq = (const float*)d_in[10]; a.kv_a_norm = (const float*)d_in[11]; a.w_ukv = (const float*)d_in[12];
    a.w_pa = (const float*)d_in[13]; a.w_pb = (const float*)d_in[14]; a.w_o = (const float*)d_in[15]; a.ln_mix_post = (const float*)d_in[16]; a.ln_ffn_pre = (const float*)d_in[17];
    a.w_g = (const float*)d_in[18]; a.w_u = (const float*)d_in[19]; a.w_d = (const float*)d_in[20]; a.ln_ffn_post = (const float*)d_in[21];
    a.out = (float*)d_out; a.ws = (unsigned char*)d_ws;
    for (int i = 0; i < 32; ++i) a.invf[i] = 1.0 / pow(10000.0, (double)i * (2.0 / 64.0));
#if MK_MULTI
    for (int ph = 0; ph < N_PHASES; ++ph) {
        a.ph_lo = ph; a.ph_hi = ph + 1;
        hipLaunchKernelGGL(fwd_kernel, dim3(grid), dim3(NTHR), LDS_BYTES, stream, a);
    }
#else
    a.ph_lo = 0; a.ph_hi = N_PHASES;
    void* args[] = {&a};
    hipError_t e = hipLaunchCooperativeKernel((const void*)fwd_kernel, dim3(grid), dim3(NTHR), args, LDS_BYTES, stream);
    if (e != hipSuccess) fprintf(stderr, "cooperative launch failed: %s (grid %d)\n", hipGetErrorString(e), grid);
#endif
}
```
